# Optimizing an MI355X kernel written in HIP

```python
import jax, jax.numpy as jnp
from jax import lax
import numpy as np

D_MODEL = 1024
BATCH = 16
SEQ = 2048
DEPTH = 4

HEAD_DIM = 64
N_Q_HEADS = 8
N_KV_HEADS = 2
Q_PER_KV = N_Q_HEADS // N_KV_HEADS
ATTN_WIDTH = N_Q_HEADS * HEAD_DIM
KV_WIDTH = N_KV_HEADS * HEAD_DIM
CONV_WIDTH = D_MODEL - ATTN_WIDTH
MIX_WIDTH = ATTN_WIDTH + CONV_WIDTH
N_MIX_HEADS = MIX_WIDTH // HEAD_DIM
Q_END = ATTN_WIDTH
K_END = Q_END + KV_WIDTH
V_END = K_END + KV_WIDTH
CB_END = V_END + CONV_WIDTH
CC_END = CB_END + CONV_WIDTH
IN_WIDTH = CC_END + CONV_WIDTH
WINDOW = 128
ATTN_BLOCK = 128
ROPE_THETA = 10000.0
CONV_K = 3
D_FF = 3584
N_EXPERTS = 8
TOP_K = 2
MOE_BLOCK = 128
N_DENSE = (DEPTH + 1) // 2
N_MOE = DEPTH // 2
NORM_EPS = 1e-5
NEG_INF = -1e30
MAX_POS_OFFSET = 4096

kernel_name = 'hybrid_swa_sink_shortconv_moe_trunk'


def rms_norm(x, w):
    xf = x.astype(jnp.float32)
    var = jnp.mean(xf * xf, axis=-1, keepdims=True)
    return (xf * lax.rsqrt(var + NORM_EPS) * w.astype(jnp.float32)).astype(x.dtype)


def rope_tables(positions):
    inv_freq = ROPE_THETA ** (-jnp.arange(0, HEAD_DIM, 2, dtype=jnp.float32) / HEAD_DIM)
    ang = positions.astype(jnp.float32)[..., None] * inv_freq
    return jnp.cos(ang)[:, :, None, :], jnp.sin(ang)[:, :, None, :]


def apply_rope(t, cos, sin):
    half = HEAD_DIM // 2
    tf = t.astype(jnp.float32)
    t1, t2 = tf[..., :half], tf[..., half:]
    return jnp.concatenate([t1 * cos - t2 * sin, t2 * cos + t1 * sin], axis=-1).astype(t.dtype)


def sliding_window_attention(q, k, v, sinks):
    B, S = q.shape[0], q.shape[1]
    nb = S // ATTN_BLOCK
    qb = q.reshape(B, nb, ATTN_BLOCK, N_KV_HEADS, Q_PER_KV, HEAD_DIM)

    def with_prev(t):
        tb = t.reshape(B, nb, ATTN_BLOCK, N_KV_HEADS, HEAD_DIM)
        prev = jnp.pad(tb[:, :-1], ((0, 0), (1, 0), (0, 0), (0, 0), (0, 0)))
        return jnp.concatenate([prev, tb], axis=2)

    kk, vv = with_prev(k), with_prev(v)
    s = jnp.einsum('bnqkgd,bnskd->bkgnqs', qb, kk).astype(jnp.float32) * (HEAD_DIM ** -0.5)
    blk = jnp.arange(nb)[:, None, None] * ATTN_BLOCK
    q_pos = blk + jnp.arange(ATTN_BLOCK)[None, :, None]
    k_pos = blk - ATTN_BLOCK + jnp.arange(2 * ATTN_BLOCK)[None, None, :]
    dist = q_pos - k_pos
    mask = (dist >= 0) & (dist < WINDOW) & (k_pos >= 0)
    s = jnp.where(mask, s, NEG_INF)
    sink = sinks.astype(jnp.float32).reshape(N_KV_HEADS, Q_PER_KV)[None, :, :, None, None, None]
    m = jnp.maximum(jnp.max(s, axis=-1, keepdims=True), sink)
    p = jnp.exp(s - m)
    p = p / (jnp.sum(p, axis=-1, keepdims=True) + jnp.exp(sink - m))
    o = jnp.einsum('bkgnqs,bnskd->bnqkgd', p.astype(v.dtype), vv)
    return o.reshape(B, S, ATTN_WIDTH)


def causal_depthwise_conv(u, w):
    S = u.shape[1]
    up = jnp.pad(u, ((0, 0), (CONV_K - 1, 0), (0, 0)))
    y = w[0] * up[:, 0:S]
    for i in range(1, CONV_K):
        y = y + w[i] * up[:, i:i + S]
    return y


def hybrid_mixer(h, cos, sin, w_in, sinks, conv_w, head_norm_w, w_out):
    B, S, _ = h.shape
    proj = h @ w_in
    q = apply_rope(proj[..., :Q_END].reshape(B, S, N_Q_HEADS, HEAD_DIM), cos, sin)
    k = apply_rope(proj[..., Q_END:K_END].reshape(B, S, N_KV_HEADS, HEAD_DIM), cos, sin)
    v = proj[..., K_END:V_END].reshape(B, S, N_KV_HEADS, HEAD_DIM)
    attn = sliding_window_attention(q, k, v, sinks)
    gate_b = proj[..., V_END:CB_END]
    gate_c = proj[..., CB_END:CC_END]
    hc = proj[..., CC_END:]
    conv = gate_b * causal_depthwise_conv(gate_c * hc, conv_w)
    y = jnp.concatenate([attn, conv], axis=-1).reshape(B, S, N_MIX_HEADS, HEAD_DIM)
    y = rms_norm(y, head_norm_w.reshape(N_MIX_HEADS, HEAD_DIM)).reshape(B, S, MIX_WIDTH)
    return y @ w_out


def swiglu(h, w_gate, w_up, w_down):
    return (jax.nn.silu(h @ w_gate) * (h @ w_up)) @ w_down


def moe_swiglu(h, router_w, w_gate, w_up, w_down):
    B, S, D = h.shape
    N = B * S
    t = h.reshape(N, D)
    logits = (t @ router_w).astype(jnp.float32)
    top_logits, top_idx = lax.top_k(logits, TOP_K)
    gates = jax.nn.softmax(top_logits, axis=-1)
    flat_e = top_idx.reshape(-1)
    flat_tok = jnp.repeat(jnp.arange(N, dtype=jnp.int32), TOP_K)
    flat_g = gates.reshape(-1)
    order = jnp.argsort(flat_e)
    sorted_e = flat_e[order]
    sizes = jnp.bincount(flat_e, length=N_EXPERTS)
    padded = (sizes + MOE_BLOCK - 1) // MOE_BLOCK * MOE_BLOCK
    group_start = jnp.cumsum(sizes) - sizes
    padded_end = jnp.cumsum(padded)
    padded_start = padded_end - padded
    n_assign = N * TOP_K
    rank = jnp.arange(n_assign, dtype=jnp.int32) - group_start[sorted_e]
    dest = padded_start[sorted_e] + rank
    n_rows = -(-n_assign // MOE_BLOCK) * MOE_BLOCK + N_EXPERTS * MOE_BLOCK
    n_blocks = n_rows // MOE_BLOCK
    row_tok = jnp.full((n_rows,), N, dtype=jnp.int32).at[dest].set(flat_tok[order])
    row_gate = jnp.zeros((n_rows,), jnp.float32).at[dest].set(flat_g[order])
    blk_e = jnp.minimum(jnp.searchsorted(padded_end, jnp.arange(n_blocks) * MOE_BLOCK, side='right'),
                        N_EXPERTS - 1)
    t_pad = jnp.concatenate([t, jnp.zeros((1, D), t.dtype)], axis=0)
    xs = t_pad[row_tok].reshape(n_blocks, MOE_BLOCK, D)

    def expert_block(args):
        xb, e = args
        return swiglu(xb, w_gate[e], w_up[e], w_down[e])

    ys = lax.map(expert_block, (xs, blk_e)).reshape(n_rows, D)
    ys = ys * row_gate[:, None].astype(ys.dtype)
    out = jnp.zeros((N + 1, D), ys.dtype).at[row_tok].add(ys)[:N]
    return out.reshape(B, S, D)


def setup_inputs(seed: int = 0) -> dict:
    key = jax.random.key(seed)
    ks = jax.random.split(key, 18)
    f32 = jnp.float32
    nrm = lambda k, shape, scale: jax.random.normal(k, shape, f32) * scale
    x = jax.random.normal(ks[0], (BATCH, SEQ, D_MODEL), f32)
    offset = jax.random.randint(ks[1], (BATCH,), 0, MAX_POS_OFFSET, dtype=jnp.int32)
    positions = offset[:, None] + jnp.arange(SEQ, dtype=jnp.int32)[None, :]
    return {
        'x': x,
        'positions': positions,
        'attn_norm_w': 1.0 + nrm(ks[2], (DEPTH, D_MODEL), 0.02),
        'w_in': nrm(ks[3], (DEPTH, D_MODEL, IN_WIDTH), D_MODEL ** -0.5),
        'attn_sinks': nrm(ks[4], (DEPTH, N_Q_HEADS), 0.5),
        'conv_w': nrm(ks[5], (DEPTH, CONV_K, CONV_WIDTH), CONV_K ** -0.5),
        'head_norm_w': 1.0 + nrm(ks[6], (DEPTH, MIX_WIDTH), 0.02),
        'w_out': nrm(ks[7], (DEPTH, MIX_WIDTH, D_MODEL), MIX_WIDTH ** -0.5),
        'ffn_norm_w': 1.0 + nrm(ks[8], (DEPTH, D_MODEL), 0.02),
        'dense_w_gate': nrm(ks[9], (N_DENSE, D_MODEL, D_FF), D_MODEL ** -0.5),
        'dense_w_up': nrm(ks[10], (N_DENSE, D_MODEL, D_FF), D_MODEL ** -0.5),
        'dense_w_down': nrm(ks[11], (N_DENSE, D_FF, D_MODEL), D_FF ** -0.5),
        'router_w': nrm(ks[12], (N_MOE, D_MODEL, N_EXPERTS), D_MODEL ** -0.5),
        'moe_w_gate': nrm(ks[13], (N_MOE, N_EXPERTS, D_MODEL, D_FF), D_MODEL ** -0.5),
        'moe_w_up': nrm(ks[14], (N_MOE, N_EXPERTS, D_MODEL, D_FF), D_MODEL ** -0.5),
        'moe_w_down': nrm(ks[15], (N_MOE, N_EXPERTS, D_FF, D_MODEL), D_FF ** -0.5),
        'final_norm_w': 1.0 + nrm(ks[16], (D_MODEL,), 0.02),
    }


def reference(x, positions, attn_norm_w, w_in, attn_sinks, conv_w, head_norm_w, w_out, ffn_norm_w,
              dense_w_gate, dense_w_up, dense_w_down, router_w, moe_w_gate, moe_w_up, moe_w_down,
              final_norm_w):
    cos, sin = rope_tables(positions)
    for l in range(DEPTH):
        h = rms_norm(x, attn_norm_w[l])
        x = x + hybrid_mixer(h, cos, sin, w_in[l], attn_sinks[l], conv_w[l], head_norm_w[l], w_out[l])
        h = rms_norm(x, ffn_norm_w[l])
        if l % 2 == 0:
            i = l // 2
            x = x + swiglu(h, dense_w_gate[i], dense_w_up[i], dense_w_down[i])
        else:
            i = l // 2
            x = x + moe_swiglu(h, router_w[i], moe_w_gate[i], moe_w_up[i], moe_w_down[i])
    return rms_norm(x, final_norm_w)
```

```cpp
#include <hip/hip_runtime.h>
#include <cstdio>
#include <cstdint>
#include <cstddef>
namespace pg8 {
#define PG8_LAS __attribute__((address_space(3)))
typedef unsigned short bf16_t;
typedef short bf16x8 __attribute__((ext_vector_type(8)));
typedef float f32x4 __attribute__((ext_vector_type(4)));
typedef unsigned u32x4 __attribute__((ext_vector_type(4)));
constexpr int BM = 256, BK = 64, HALF = 128, HTB = HALF * BK * 2  , STAGE_BYTES = 8 * HTB, NXCD = 8, WGM = 8;

__host__ __device__ __forceinline__ int lds_byte(int r, int c) { const int st = (r >> 4) * 2 + (c >> 5), rr = r & 15, cc = c & 31, ob = rr * 64 + cc * 2; return st * 1024 + (ob ^ (((ob >> 9) & 1) << 5)); }
__host__ __device__ __forceinline__ void stage_rc(int b, int& R, int& C) { const int st = b / 1024, sb = b % 1024, swz = sb ^ (((sb >> 9) & 1) << 5); R = (st >> 1) * 16 + swz / 64; C = (st & 1) * 32 + (swz % 64) / 2; }
__host__ __device__ __forceinline__ int perm32(int rho) { const int n = rho >> 4, i = rho & 15; return 8 * (i >> 2) + 4 * n + (i & 3); }

struct Unit { int pm, pn, pe; };
struct Gemm { const bf16_t* A; const bf16_t* Bt; int M, N, K; size_t estep; };

struct StaticOrder {
    int nM, nN, nwg, G, c;
    __host__ __device__ void init(int M, int N, int G_, int c_) { nM = M / BM; nN = N / BM; nwg = nM * nN; G = G_; c = c_; }
    __host__ __device__ bool next(int i, Unit& u) const {
        const long L = (long)i * G + c; if (L >= nwg) return false;
        int wgid = (int)L; { const int q = nwg / NXCD, r = nwg % NXCD, xcd = wgid % NXCD, off = wgid / NXCD; wgid = (xcd < r ? xcd * (q + 1) : r * (q + 1) + (xcd - r) * q) + off; }
        const int nig = WGM * nN, gid = wgid / nig, fm = gid * WGM, gsz = (nM - fm) < WGM ? (nM - fm) : WGM;
        u.pm = fm + ((wgid % nig) % gsz); u.pn = (wgid % nig) / gsz; u.pe = 0; return true;
    }
    __device__ __forceinline__ void a_ready(const Unit&) const {}
    __device__ __forceinline__ void done(const Unit&) const {}
};

__device__ __forceinline__ unsigned cvt_pk_bf16(float lo, float hi) { unsigned r; asm volatile("v_cvt_pk_bf16_f32 %0, %1, %2" : "=v"(r) : "v"(lo), "v"(hi)); return r; }
typedef float f32x2 __attribute__((ext_vector_type(2)));

typedef unsigned u32x2 __attribute__((ext_vector_type(2)));
constexpr float NORM_EPS = 1e-5f;
__device__ __forceinline__ float row_rstd(const float* ssq, int row) {
    const f32x4 s = *(const f32x4*)(ssq + (size_t)row * 4);
    return __builtin_amdgcn_rsqf(((s[0] + s[1]) + (s[2] + s[3])) * (1.0f / 1024.0f) + NORM_EPS);
}
__device__ __forceinline__ float silu_mul(float g, float u) {
    const float e = __builtin_amdgcn_exp2f(-1.4426950408889634f * g);
    return g * u * __builtin_amdgcn_rcpf(1.0f + e);
}
struct EpiIn {
    static constexpr bool PERM = true, AFTER_DRAIN = false;
    bf16_t* P; const float* ssq; const float* rc; const float* rsn; float qscale;
    __device__ __forceinline__ void operator()(const f32x4 (&acc)[2][2][4][2], const Unit& u, int wr, int wc, int fr, int fq) const {
        const int row0 = u.pm * BM + wr * 64 + fr;
        const int colb = u.pn * BM + wc * 64 + 8 * fq;
        const bool rope = (u.pn < 2) || (u.pn == 2 && wc < 2);
        const float sc = (u.pn < 2) ? qscale : 1.0f;
#pragma unroll
        for (int ai = 0; ai < 2; ++ai)
#pragma unroll
            for (int m = 0; m < 4; ++m) {
                const int row = row0 + ai * HALF + m * 16;
                const float rs = row_rstd(ssq, row);
                f32x4 a0 = acc[ai][0][m][0] * rs, a1 = acc[ai][0][m][1] * rs, b0 = acc[ai][1][m][0] * rs, b1 = acc[ai][1][m][1] * rs;
                if (rope) {
                    const float* cp = rc + (size_t)row * 32 + 8 * fq; const float* sp = rsn + (size_t)row * 32 + 8 * fq;
                    const f32x4 c0 = *(const f32x4*)cp, c1 = *(const f32x4*)(cp + 4), s0 = *(const f32x4*)sp, s1 = *(const f32x4*)(sp + 4);
                    const f32x4 o0 = (a0 * c0 - b0 * s0) * sc, o1 = (a1 * c1 - b1 * s1) * sc, p0 = (b0 * c0 + a0 * s0) * sc, p1 = (b1 * c1 + a1 * s1) * sc;
                    a0 = o0; a1 = o1; b0 = p0; b1 = p1;
                }
                bf16_t* rp = P + (size_t)row * 2304 + colb;
                u32x4 w; w.x = cvt_pk_bf16(a0[0], a0[1]); w.y = cvt_pk_bf16(a0[2], a0[3]); w.z = cvt_pk_bf16(a1[0], a1[1]); w.w = cvt_pk_bf16(a1[2], a1[3]);
                *(u32x4*)rp = w;
                u32x4 v; v.x = cvt_pk_bf16(b0[0], b0[1]); v.y = cvt_pk_bf16(b0[2], b0[3]); v.z = cvt_pk_bf16(b1[0], b1[1]); v.w = cvt_pk_bf16(b1[2], b1[3]);
                *(u32x4*)(rp + 32) = v;
            }
    }
};
struct EpiRes {
    static constexpr bool PERM = false, AFTER_DRAIN = false;
    const float* res; float* X; bf16_t* XB; float* ssq; PG8_LAS float* tbl;
    __device__ __forceinline__ void operator()(const f32x4 (&acc)[2][2][4][2], const Unit& u, int wr, int wc, int fr, int fq) const {
        const int col0 = u.pn * BM + wc * 32 + 4 * fq;
#pragma unroll
        for (int ai = 0; ai < 2; ++ai)
#pragma unroll
            for (int m = 0; m < 4; ++m) {
                const int rowl = ai * HALF + wr * 64 + m * 16 + fr; const size_t off = (size_t)(u.pm * BM + rowl) * 1024 + col0; float sq = 0.f;
#pragma unroll
                for (int bj = 0; bj < 2; ++bj)
#pragma unroll
                    for (int n = 0; n < 2; ++n) {
                        const size_t o = off + bj * HALF + n * 16;
                        const f32x4 r = *(const f32x4*)(res + o); const f32x4 x = r + acc[ai][bj][m][n];
                        *(f32x4*)(X + o) = x;
                        u32x2 w; w.x = cvt_pk_bf16(x[0], x[1]); w.y = cvt_pk_bf16(x[2], x[3]); *(u32x2*)(XB + o) = w;
                        sq += (x[0] * x[0] + x[1] * x[1]) + (x[2] * x[2] + x[3] * x[3]);
                    }
                sq += __shfl_xor(sq, 16); sq += __shfl_xor(sq, 32);
                if (fq == 0) tbl[rowl * 4 + wc] = sq;
            }
        asm volatile("s_waitcnt lgkmcnt(0)" ::: "memory"); __builtin_amdgcn_s_barrier(); asm volatile("" ::: "memory");
        const int lane = fq * 16 + fr;
        if (lane < 32) {
            const int rowl = (wc >> 1) * HALF + wr * 64 + (wc & 1) * 32 + lane;
            const f32x4 t = *(const PG8_LAS f32x4*)(tbl + rowl * 4);
            ssq[(size_t)(u.pm * BM + rowl) * 4 + u.pn] = (t[0] + t[1]) + (t[2] + t[3]);
        }
    }
};
struct EpiUp {
    static constexpr bool PERM = true, AFTER_DRAIN = false;
    bf16_t* O; int ldc; const float* ssq;
    __device__ __forceinline__ void operator()(const f32x4 (&acc)[2][2][4][2], const Unit& u, int wr, int wc, int fr, int fq) const {
        const int row0 = u.pm * BM + wr * 64 + fr, col0 = u.pn * HALF + wc * 32 + 8 * fq;
#pragma unroll
        for (int ai = 0; ai < 2; ++ai)
#pragma unroll
            for (int m = 0; m < 4; ++m) {
                const int row = row0 + ai * HALF + m * 16;
                const float rs = ssq ? row_rstd(ssq, row) : 1.0f;
                const f32x4 g0 = acc[ai][0][m][0] * rs, g1 = acc[ai][0][m][1] * rs, u0 = acc[ai][1][m][0] * rs, u1 = acc[ai][1][m][1] * rs;
                u32x4 w;
                w.x = cvt_pk_bf16(silu_mul(g0[0], u0[0]), silu_mul(g0[1], u0[1])); w.y = cvt_pk_bf16(silu_mul(g0[2], u0[2]), silu_mul(g0[3], u0[3]));
                w.z = cvt_pk_bf16(silu_mul(g1[0], u1[0]), silu_mul(g1[1], u1[1])); w.w = cvt_pk_bf16(silu_mul(g1[2], u1[2]), silu_mul(g1[3], u1[3]));
                *(u32x4*)(O + (size_t)row * ldc + col0) = w;
            }
    }
};
struct EpiYs {
    static constexpr bool PERM = true, AFTER_DRAIN = false;
    bf16_t* O; int ldc;
    __device__ __forceinline__ void operator()(const f32x4 (&acc)[2][2][4][2], const Unit& u, int wr, int wc, int fr, int fq) const {
        const int row0 = u.pm * BM + wr * 64 + fr, col0 = u.pn * BM + wc * 32 + 8 * fq;
#pragma unroll
        for (int ai = 0; ai < 2; ++ai)
#pragma unroll
            for (int m = 0; m < 4; ++m) { bf16_t* rowp = O + (size_t)(row0 + ai * HALF + m * 16) * ldc + col0;
#pragma unroll
                for (int bj = 0; bj < 2; ++bj) { const f32x4 v0 = acc[ai][bj][m][0], v1 = acc[ai][bj][m][1];
                    u32x4 w; w.x = cvt_pk_bf16(v0[0], v0[1]); w.y = cvt_pk_bf16(v0[2], v0[3]); w.z = cvt_pk_bf16(v1[0], v1[1]); w.w = cvt_pk_bf16(v1[2], v1[3]);
                    *(u32x4*)(rowp + bj * HALF) = w; } }
    }
};
struct MoeOrder : StaticOrder {
    int tend[8];
    __device__ __forceinline__ bool next(int i, Unit& u) const {
        if (!StaticOrder::next(i, u)) return false;
        int e = 0;
#pragma unroll
        for (int j = 0; j < 7; ++j) e += (u.pm >= tend[j]) ? 1 : 0;
        u.pe = e; return true;
    }
};

template <class Epi, class Sched, bool ALIGN_EPI = false, bool SP2 = false>
__device__ __forceinline__ void gemm_phase(PG8_LAS unsigned char* lds, const Gemm g, const Sched& S, const Epi& E) {
    int tid_ = threadIdx.x; asm volatile("" : "+v"(tid_));
    const int tid = tid_, wid = __builtin_amdgcn_readfirstlane(tid >> 6), lane = tid & 63, wr = wid >> 2, wc = wid & 3, fr = lane & 15, fq = lane >> 4;
    const int K = g.K, nt = K / BK;
    unsigned voffA[2], voffB[2];
#pragma unroll
    for (int i = 0; i < 2; ++i) { int R, C; stage_rc(tid * 16 + i * 8192, R, C); const int Rb = Epi::PERM ? ((R & ~31) + perm32(R & 31)) : R;
        voffA[i] = (unsigned)(R * K + C) * 2u; voffB[i] = (unsigned)(Rb * K + C) * 2u; }
    const size_t kstep = (size_t)(BK * 2);
    const size_t hstep = (size_t)HALF * K * 2;
    const size_t tstep = 2 * hstep;
    const unsigned ldsw = (unsigned)wid * 1024u;
    const int aoff = lds_byte(wr * 64 + fr, fq * 8), boff = lds_byte(wc * 32 + fr, fq * 8);
#define PG8_SA(b, h) (((b) * 2 + (h)) * HTB)
#define PG8_SB(b, h) ((4 + (b) * 2 + (h)) * HTB)
#define PG8_STAGE(bufoff, gbase, voff) do { _Pragma("unroll") for (int _i = 0; _i < 2; ++_i) \
        __builtin_amdgcn_global_load_lds((const unsigned*)((const char*)(gbase) + (voff)[_i]), (PG8_LAS unsigned*)(lds + (bufoff) + ldsw + _i * 8192), 16, 0, 0); } while (0)
#define PG8_LDA(dst, b, h) do { _Pragma("unroll") for (int m = 0; m < 4; ++m) _Pragma("unroll") for (int k = 0; k < 2; ++k) dst[m][k] = *(const PG8_LAS bf16x8*)(lds + PG8_SA(b, h) + aoff + m * 2048 + k * 1024); } while (0)
#define PG8_LDB(dst, b, h) do { _Pragma("unroll") for (int n = 0; n < 2; ++n) _Pragma("unroll") for (int k = 0; k < 2; ++k) dst[n][k] = *(const PG8_LAS bf16x8*)(lds + PG8_SB(b, h) + boff + n * 2048 + k * 1024); } while (0)
#define PG8_MMA(ai, bj, At, Bt) do { __builtin_amdgcn_s_setprio(1); _Pragma("unroll") for (int m = 0; m < 4; ++m) _Pragma("unroll") for (int n = 0; n < 2; ++n) _Pragma("unroll") for (int k = 0; k < 2; ++k) \
        acc[ai][bj][m][n] = __builtin_amdgcn_mfma_f32_16x16x32_bf16(Bt[n][k], At[m][k], acc[ai][bj][m][n], 0, 0, 0); __builtin_amdgcn_s_setprio(0); } while (0)
#define PG8_WAIT_V(n) asm volatile("s_waitcnt vmcnt(" #n ")" ::: "memory")
#define PG8_WAIT_L(n) asm volatile("s_waitcnt lgkmcnt(" #n ")" ::: "memory")
#define PG8_BAR __builtin_amdgcn_s_barrier()
#define PG8_SCHED __builtin_amdgcn_sched_barrier(0)
    Unit cur, nxt; int ui = 0;
    if (!S.next(0, cur)) return;
    f32x4 acc[2][2][4][2];
#pragma unroll
    for (int a = 0; a < 2; ++a)
#pragma unroll
        for (int b = 0; b < 2; ++b)
#pragma unroll
            for (int m = 0; m < 4; ++m)
#pragma unroll
                for (int n = 0; n < 2; ++n) acc[a][b][m][n] = (f32x4){0.f, 0.f, 0.f, 0.f};
    bf16x8 At[4][2], B0[2][2], B1[2][2];
    const char* cA = (const char*)g.A + (size_t)cur.pm * tstep; const char* cB = (const char*)g.Bt + (size_t)cur.pe * g.estep + (size_t)cur.pn * tstep;
    S.a_ready(cur);
    if constexpr (SP2) {
        PG8_STAGE(PG8_SB(0, 0), cB, voffB); PG8_STAGE(PG8_SB(0, 1), cB + hstep, voffB); PG8_STAGE(PG8_SA(0, 0), cA, voffA); PG8_STAGE(PG8_SA(0, 1), cA + hstep, voffA);
        if (wr == 1) PG8_BAR;
        PG8_WAIT_V(2); PG8_BAR;
        PG8_STAGE(PG8_SB(1, 0), cB + kstep, voffB); PG8_STAGE(PG8_SA(1, 0), cA + kstep, voffA); PG8_STAGE(PG8_SB(1, 1), cB + hstep + kstep, voffB);
        PG8_WAIT_V(6); PG8_BAR;
    } else {
        PG8_STAGE(PG8_SB(0, 0), cB, voffB); PG8_STAGE(PG8_SA(0, 0), cA, voffA); PG8_STAGE(PG8_SB(0, 1), cB + hstep, voffB); PG8_STAGE(PG8_SA(0, 1), cA + hstep, voffA);
        if (wr == 1) PG8_BAR;
        PG8_WAIT_V(4); PG8_BAR;
        PG8_STAGE(PG8_SB(1, 0), cB + kstep, voffB); PG8_STAGE(PG8_SA(1, 0), cA + kstep, voffA); PG8_STAGE(PG8_SB(1, 1), cB + hstep + kstep, voffB);
        PG8_WAIT_V(6); PG8_BAR;
    }
    for (;;) {
        const bool has_next = S.next(ui + 1, nxt);
        const char* nA = has_next ? (const char*)g.A + (size_t)nxt.pm * tstep : cA; const char* nB = has_next ? (const char*)g.Bt + (size_t)nxt.pe * g.estep + (size_t)nxt.pn * tstep : cB;
        for (int t = 0; t < nt; t += 2) {
            const bool last = (t == nt - 2);
            const char* a1 = cA + (size_t)(t + 1) * kstep;
            const char* a2 = last ? nA : cA + (size_t)(t + 2) * kstep; const char* b2 = last ? nB : cB + (size_t)(t + 2) * kstep;
            const char* a3 = a2 + kstep; const char* b3 = b2 + kstep;
            if (last && has_next) S.a_ready(nxt);
            if constexpr (SP2) {
            PG8_LDB(B0, 0, 0); PG8_LDB(B1, 0, 1); PG8_SCHED; PG8_LDA(At, 0, 0); PG8_STAGE(PG8_SA(1, 1), a1 + hstep, voffA);
            PG8_WAIT_V(8); PG8_WAIT_L(0); PG8_BAR; PG8_MMA(0, 0, At, B0); PG8_MMA(0, 1, At, B1); PG8_BAR; PG8_SCHED;
            PG8_LDA(At, 0, 1); PG8_STAGE(PG8_SB(0, 0), b2, voffB); PG8_STAGE(PG8_SB(0, 1), b2 + hstep, voffB); PG8_STAGE(PG8_SA(0, 0), a2, voffA);
            PG8_WAIT_V(8); PG8_WAIT_L(0); PG8_BAR; PG8_MMA(1, 0, At, B0); PG8_MMA(1, 1, At, B1); PG8_BAR; PG8_SCHED;
            PG8_LDB(B0, 1, 0); PG8_LDB(B1, 1, 1); PG8_SCHED; PG8_LDA(At, 1, 0); PG8_STAGE(PG8_SA(0, 1), a2 + hstep, voffA);
            PG8_WAIT_V(8); PG8_WAIT_L(0); PG8_BAR; PG8_MMA(0, 0, At, B0); PG8_MMA(0, 1, At, B1); PG8_BAR; PG8_SCHED;
            PG8_LDA(At, 1, 1); PG8_STAGE(PG8_SB(1, 0), b3, voffB); PG8_STAGE(PG8_SB(1, 1), b3 + hstep, voffB); PG8_STAGE(PG8_SA(1, 0), a3, voffA);
            PG8_WAIT_V(8); PG8_WAIT_L(0); PG8_BAR; PG8_MMA(1, 0, At, B0); PG8_MMA(1, 1, At, B1); PG8_BAR; PG8_SCHED;
            } else {
            PG8_LDB(B0, 0, 0); PG8_SCHED; PG8_LDA(At, 0, 0); PG8_STAGE(PG8_SA(1, 1), a1 + hstep, voffA);
            PG8_WAIT_L(8); PG8_BAR; PG8_WAIT_L(0); PG8_MMA(0, 0, At, B0); PG8_BAR; PG8_SCHED;
            PG8_LDB(B1, 0, 1); PG8_STAGE(PG8_SB(0, 0), b2, voffB);
            PG8_BAR; PG8_WAIT_L(0); PG8_MMA(0, 1, At, B1); PG8_BAR;
            PG8_LDA(At, 0, 1); PG8_STAGE(PG8_SA(0, 0), a2, voffA);
            PG8_BAR; PG8_WAIT_L(0); PG8_MMA(1, 0, At, B0); PG8_BAR; PG8_SCHED;
            PG8_STAGE(PG8_SB(0, 1), b2 + hstep, voffB);
            PG8_WAIT_V(6); PG8_BAR; PG8_MMA(1, 1, At, B1); PG8_BAR;
            PG8_LDB(B0, 1, 0); PG8_SCHED; PG8_LDA(At, 1, 0); PG8_STAGE(PG8_SA(0, 1), a2 + hstep, voffA);
            PG8_WAIT_L(8); PG8_BAR; PG8_WAIT_L(0); PG8_MMA(0, 0, At, B0); PG8_BAR; PG8_SCHED;
            PG8_LDB(B1, 1, 1); PG8_STAGE(PG8_SB(1, 0), b3, voffB);
            PG8_BAR; PG8_WAIT_L(0); PG8_MMA(0, 1, At, B1); PG8_BAR;
            PG8_LDA(At, 1, 1); PG8_STAGE(PG8_SA(1, 0), a3, voffA);
            PG8_BAR; PG8_WAIT_L(0); PG8_MMA(1, 0, At, B0); PG8_BAR; PG8_SCHED;
            PG8_STAGE(PG8_SB(1, 1), b3 + hstep, voffB);
            PG8_WAIT_V(6); PG8_BAR; PG8_MMA(1, 1, At, B1); PG8_BAR;
            }
        }
        if constexpr (ALIGN_EPI) { if (wr == 0) PG8_BAR; }
        if constexpr (!Epi::AFTER_DRAIN) { E(acc, cur, wr, wc, fr, fq); S.done(cur); }
        if (!has_next) break;
#pragma unroll
        for (int a = 0; a < 2; ++a)
#pragma unroll
            for (int b = 0; b < 2; ++b)
#pragma unroll
                for (int m = 0; m < 4; ++m)
#pragma unroll
                    for (int n = 0; n < 2; ++n) acc[a][b][m][n] = (f32x4){0.f, 0.f, 0.f, 0.f};
        cur = nxt; cA = nA; cB = nB; ++ui;
        if constexpr (ALIGN_EPI) { if (wr == 1) PG8_BAR; }
    }
    PG8_WAIT_V(0);
    if constexpr (!ALIGN_EPI) { if (wr == 0) PG8_BAR; }
    PG8_BAR;
    if constexpr (Epi::AFTER_DRAIN) { E.fused(acc, cur, wr, wc, fr, fq, lds, wid, lane); S.done(cur); }
#undef PG8_SA
#undef PG8_SB
#undef PG8_STAGE
#undef PG8_LDA
#undef PG8_LDB
#undef PG8_MMA
#undef PG8_WAIT_V
#undef PG8_WAIT_L
#undef PG8_BAR
#undef PG8_SCHED
}
}

#define GAS __attribute__((address_space(1)))
#define LAS __attribute__((address_space(3)))
typedef unsigned short bf16;
typedef unsigned v4u __attribute__((ext_vector_type(4)));
typedef float f32x4 __attribute__((ext_vector_type(4)));
typedef short bf16x8 __attribute__((ext_vector_type(8)));
typedef GAS unsigned gu32;
typedef GAS unsigned long long gu64;
#define RLX_AGENT __ATOMIC_RELAXED, __HIP_MEMORY_SCOPE_AGENT
#define LDS_WAIT() asm volatile("s_waitcnt lgkmcnt(0)" ::: "memory")
#define VM_WAIT() asm volatile("s_waitcnt vmcnt(0)" ::: "memory")
__device__ __forceinline__ unsigned long long rt() { return __builtin_amdgcn_s_memrealtime(); }
__device__ __forceinline__ unsigned f2bf(float f) { unsigned u = __builtin_bit_cast(unsigned, f); return (u + 0x7fffu + ((u >> 16) & 1u)) >> 16; }
__device__ __forceinline__ unsigned pk2(float lo, float hi) { return f2bf(lo) | (f2bf(hi) << 16); }

#define XB_TMO      128
#define XB_XCNT(j)  (256  + 64 * (j))
#define XB_XSUB(j)  (1280 + 64 * (j))
#define XB_XGEN(j)  (2304 + 64 * (j))
#define XB_TOP      3328
#define XB_TOPGEN   3392
#define XCD_BAR_WORDS 3456
#define XB_SPIN_CAP (1u << 18)

__device__ __forceinline__ unsigned xb_ld(unsigned* p)              { return __hip_atomic_load(p, __ATOMIC_RELAXED, __HIP_MEMORY_SCOPE_AGENT); }
__device__ __forceinline__ unsigned xb_add(unsigned* p, unsigned v) { return __hip_atomic_fetch_add(p, v, __ATOMIC_RELAXED, __HIP_MEMORY_SCOPE_AGENT); }
__device__ __forceinline__ unsigned xb_xcc_id() { return (unsigned)__builtin_amdgcn_s_getreg((3 << 11) | 20) & 0xFu; }
#define XB_SPIN(cond, bar) do { unsigned _sp = 0; while (cond) { __builtin_amdgcn_s_sleep(1); \
    if ((++_sp & 255u) == 0u) { if (xb_ld(&(bar)[XB_TMO])) break; if (_sp > XB_SPIN_CAP) { atomicAdd(&(bar)[XB_TMO], 1u); break; } } } } while (0)

struct XcdBarrier {
    unsigned* bar; unsigned x;
    volatile LAS unsigned* st;
};

__device__ __forceinline__ XcdBarrier xcd_barrier_post(unsigned* bar, volatile LAS unsigned* st) {
    XcdBarrier b; b.bar = bar; b.x = xb_xcc_id(); b.st = st;
    if (threadIdx.x == 0) (void)xb_add(&bar[XB_XCNT(b.x)], 1u);
    return b;
}
__device__ __forceinline__ void xcd_barrier_complete(unsigned* bar, unsigned x, unsigned& nloc, unsigned& nx) {
    const unsigned G = gridDim.x * gridDim.y * gridDim.z;
    unsigned sum, cnt, mine, sp = 0u;
    for (;;) {
        sum = 0u; cnt = 0u; mine = 0u;
#pragma unroll
        for (unsigned j = 0; j < 16; ++j) { const unsigned c = xb_ld(&bar[XB_XCNT(j)]); sum += c; cnt += (c > 0u) ? 1u : 0u; mine = (j == x) ? c : mine; }
        if (sum == G) break;
        __builtin_amdgcn_s_sleep(1);
        if ((++sp & 255u) == 0u) { if (xb_ld(&bar[XB_TMO])) break; if (sp > XB_SPIN_CAP) { atomicAdd(&bar[XB_TMO], 1u); break; } }
    }
    nloc = mine > 0u ? mine : 1u; nx = cnt > 0u ? cnt : 1u;
}

__device__ __forceinline__ void xcd_barrier(const XcdBarrier& b) {
    asm volatile("s_waitcnt vmcnt(0)" ::: "memory");
    __syncthreads();
    if (threadIdx.x == 0) {
        unsigned* bar = b.bar;
        __builtin_amdgcn_s_waitcnt(0);
        unsigned nloc = b.st[0], nx = b.st[1];
        if (nloc == 0u) { xcd_barrier_complete(bar, b.x, nloc, nx); b.st[0] = nloc; b.st[1] = nx; }
        const unsigned old = xb_add(&bar[XB_XSUB(b.x)], 1u);
        const unsigned gen = old / nloc;
        if (old + 1u == (gen + 1u) * nloc) {
            __builtin_amdgcn_fence(__ATOMIC_RELEASE, "agent");
            asm volatile("s_waitcnt vmcnt(0)" ::: "memory");
            const unsigned og = xb_add(&bar[XB_TOP], 1u);
            const unsigned tg = og / nx;
            if (og + 1u == (tg + 1u) * nx) xb_add(&bar[XB_TOPGEN], 1u);
            else XB_SPIN(xb_ld(&bar[XB_TOPGEN]) == tg, bar);
            __builtin_amdgcn_fence(__ATOMIC_ACQUIRE, "agent");
            xb_add(&bar[XB_XGEN(b.x)], 1u);
            asm volatile("s_waitcnt vmcnt(0)" ::: "memory");
        } else {
            XB_SPIN(xb_ld(&bar[XB_XGEN(b.x)]) == gen, bar);
            __builtin_amdgcn_fence(__ATOMIC_ACQUIRE, "agent");
            asm volatile("s_waitcnt vmcnt(0)" ::: "memory");
        }
    }
    __syncthreads();
}


constexpr int NWAVES = 8;
constexpr int NTOK = 32768, DM = 1024, SEQ = 2048, INW = 2304, FF = 3584, NE = 8, DEPTH = 4;
constexpr int COL_K = 512, COL_V = 640, COL_CB = 768, COL_CC = 1280, COL_HC = 1792;
constexpr int MOE_TILES_CAP = 2 * NTOK / 256 + NE;
constexpr int MOE_ROWS_CAP = MOE_TILES_CAP * 256;
constexpr float EPS = 1e-5f;
constexpr float LOG2E = 1.4426950408889634f;
constexpr float QSCALE = 0.125f * LOG2E;
#ifndef MK_PER_PHASE
#define MK_PER_PHASE 1
#endif
#ifndef ATTN_NAIVE
#define ATTN_NAIVE 1
#endif

constexpr size_t MiB = 1u << 20;
constexpr size_t WS_CTL = 0, CTL_ZERO_BYTES = 1 * MiB;
constexpr size_t WS_WIN = 1 * MiB;
constexpr size_t WS_WOUT = 19 * MiB;
constexpr size_t WS_WDUP = 27 * MiB;
constexpr size_t WS_WDDN = 55 * MiB;
constexpr size_t WS_WMUP = 69 * MiB;
constexpr size_t WS_WMDN = 181 * MiB;
constexpr size_t WS_ROPEC = 237 * MiB, WS_ROPES = 241 * MiB;
constexpr size_t WS_XB = 245 * MiB;
constexpr size_t WS_SSQ = 309 * MiB;
constexpr size_t WS_RT = 310 * MiB;
constexpr size_t WS_LIST = 311 * MiB;
constexpr size_t WS_ACT = 312 * MiB;
constexpr size_t WS_PROJ = WS_ACT, WS_Y = WS_ACT + 144 * MiB;
constexpr size_t WS_YS = 774 * MiB;
constexpr size_t WS_END = 906 * MiB;
static_assert(WS_ACT + (size_t)MOE_ROWS_CAP * FF * 2 <= WS_YS && WS_YS + (size_t)MOE_ROWS_CAP * DM * 2 <= WS_END, "ws map");
static_assert((size_t)NTOK * INW * 2 <= 144 * MiB, "proj fits");
constexpr int CW_BAR = 4096;
constexpr int CW_MOECNT = 16384;

constexpr int RING_OFF = 0, RING_BYTES = 131072;
constexpr int LDSCTL_OFF = RING_BYTES, MISC_OFF = LDSCTL_OFF + 320;
constexpr int SSQT_OFF = RING_BYTES + 1024;
constexpr int LDS_BYTES = 147456;
static_assert(SSQT_OFF + 4096 <= LDS_BYTES, "LDS map");

__device__ __forceinline__ float wave_sum(float v) {
#pragma unroll
    for (int o = 1; o < 64; o <<= 1) v += __shfl_xor(v, o);
    return v;
}
__device__ __forceinline__ float wave_max(float v) {
#pragma unroll
    for (int o = 1; o < 64; o <<= 1) v = fmaxf(v, __shfl_xor(v, o));
    return v;
}
typedef unsigned v2u __attribute__((ext_vector_type(2)));
__device__ __forceinline__ float bf2f(unsigned short b) { return __builtin_bit_cast(float, (unsigned)b << 16); }
__device__ __forceinline__ float bflo(unsigned w) { return __builtin_bit_cast(float, w << 16); }
__device__ __forceinline__ float bfhi(unsigned w) { return __builtin_bit_cast(float, w & 0xffff0000u); }

__device__ __forceinline__ void tr_item(const float* W, int ldw, int k0, int n0, bf16* WT, int ldt, int r0, const float* kscale, LAS float* scr, int lane) {
#pragma unroll 8
    for (int i = 0; i < 32; ++i) { const int kk = 2 * i + (lane >> 5); float v = W[(size_t)(k0 + kk) * ldw + n0 + (lane & 31)]; if (kscale) v *= kscale[k0 + kk]; scr[kk * 33 + (lane & 31)] = v; }
    LDS_WAIT(); asm volatile("" ::: "memory");
    const int c = lane & 7;
#pragma unroll
    for (int j = 0; j < 4; ++j) { const int n = (lane >> 3) + 8 * j; const LAS float* s = scr + (8 * c) * 33 + n;
        v4u o; o.x = pk2(s[0 * 33], s[1 * 33]); o.y = pk2(s[2 * 33], s[3 * 33]); o.z = pk2(s[4 * 33], s[5 * 33]); o.w = pk2(s[6 * 33], s[7 * 33]);
        *(GAS v4u*)(WT + (size_t)(r0 + n) * ldt + k0 + 8 * c) = o; }
    LDS_WAIT(); asm volatile("" ::: "memory");
}

struct Args { const float* in[17]; float* out; unsigned char* ws; int ph_lo, ph_hi; };
typedef const __attribute__((address_space(4))) Args* KA;
enum { I_X = 0, I_POS, I_ANW, I_WIN, I_SINK, I_CONVW, I_HNW, I_WOUT, I_FNW, I_DG, I_DU, I_DD, I_RW, I_MG, I_MU, I_MD, I_FINW };

__device__ const double INVF_REV[32] = {
    0.15915494309189535, 0.11934937021124886, 0.08949940160889101, 0.06711508300522726,
    0.050329212104487035, 0.03774158471741977, 0.0283021958306234, 0.02122365276477766,
    0.015915494309189534, 0.011934937021124886, 0.008949940160889102, 0.006711508300522725,
    0.005032921210448704, 0.003774158471741977, 0.00283021958306234, 0.0021223652764777662,
    0.0015915494309189536, 0.0011934937021124885, 0.0008949940160889102, 0.0006711508300522726,
    0.0005032921210448703, 0.00037741584717419774, 0.00028302195830623395, 0.0002122365276477766,
    0.00015915494309189535, 0.00011934937021124886, 8.949940160889102e-05, 6.711508300522725e-05,
    5.0329212104487035e-05, 3.774158471741978e-05, 2.8302195830623396e-05, 2.122365276477766e-05
};

__device__ __forceinline__ void p_prologue(KA a, unsigned char* ws, LAS unsigned char* lds, int gw, int NGW, int wave, int lane, int gtid, int NGT) {
    LAS float* scr = (LAS float*)(lds + RING_OFF + wave * 16384);
    constexpr int I_IN = 16 * 72, I_OUT = 16 * 32, I_G = 16 * 112, I_D = 56 * 32;
    constexpr int NITEMS = 4 * I_IN + 4 * I_OUT + 2 * I_G + 2 * I_G + 2 * I_D;
    for (int it = gw; it < NITEMS; it += NGW) {
        int r = it;
        if (r < 4 * I_IN) { const int l = r / I_IN, q = r % I_IN, kb = q / 72, nb = q % 72, n0 = 32 * nb, pn = n0 >> 8, loc = n0 & 255, wc = loc >> 6, bj = (loc >> 5) & 1;
            tr_item(a->in[I_WIN] + (size_t)l * DM * INW, INW, 64 * kb, n0, (bf16*)(ws + WS_WIN) + (size_t)l * INW * DM, DM, 256 * pn + 128 * bj + 32 * wc, a->in[I_ANW] + l * DM, scr, lane); continue; }
        r -= 4 * I_IN;
        if (r < 4 * I_OUT) { const int l = r / I_OUT, q = r % I_OUT, kb = q / 32, nb = q % 32;
            tr_item(a->in[I_WOUT] + (size_t)l * DM * DM, DM, 64 * kb, 32 * nb, (bf16*)(ws + WS_WOUT) + (size_t)l * DM * DM, DM, 32 * nb, nullptr, scr, lane); continue; }
        r -= 4 * I_OUT;
        if (r < 4 * I_G) { const int sel = r / (2 * I_G), rr = r % (2 * I_G), i = rr / I_G, q = rr % I_G, kb = q / 112, nb = q % 112, n0 = 32 * nb, pn = n0 >> 7, j0 = n0 & 127;
            tr_item(a->in[sel ? I_DU : I_DG] + (size_t)i * DM * FF, FF, 64 * kb, n0, (bf16*)(ws + WS_WDUP) + (size_t)i * 2 * FF * DM, DM, 256 * pn + 128 * sel + j0, a->in[I_FNW] + (2 * i) * DM, scr, lane); continue; }
        r -= 4 * I_G;
        { const int i = r / I_D, q = r % I_D, kb = q / 32, nb = q % 32;
            tr_item(a->in[I_DD] + (size_t)i * FF * DM, DM, 64 * kb, 32 * nb, (bf16*)(ws + WS_WDDN) + (size_t)i * DM * FF, FF, 32 * nb, nullptr, scr, lane); }
    }
    { const int* pos = (const int*)a->in[I_POS]; float* rc = (float*)(ws + WS_ROPEC); float* rs = (float*)(ws + WS_ROPES);
      for (int i = gtid; i < NTOK * 32; i += NGT) { const int t = i >> 5, j = i & 31; double r = (double)pos[t] * INVF_REV[j]; r -= floor(r);
          rc[i] = (float)cospi(2.0 * r); rs[i] = (float)sinpi(2.0 * r); } }
    { const float* x = a->in[I_X]; bf16* xb = (bf16*)(ws + WS_XB); float* ssq = (float*)(ws + WS_SSQ);
      for (int m = gw; m < NTOK; m += NGW) { const GAS f32x4* xr = (const GAS f32x4*)(x + (size_t)m * DM) + lane; float s = 0.f; f32x4 v[4];
#pragma unroll
          for (int j = 0; j < 4; ++j) { v[j] = xr[64 * j]; s += (v[j].x * v[j].x + v[j].y * v[j].y) + (v[j].z * v[j].z + v[j].w * v[j].w); }
          s = wave_sum(s);
          GAS unsigned long long* o8 = (GAS unsigned long long*)(xb + (size_t)m * DM) + lane;
#pragma unroll
          for (int j = 0; j < 4; ++j) o8[64 * j] = (unsigned long long)pk2(v[j].x, v[j].y) | ((unsigned long long)pk2(v[j].z, v[j].w) << 32);
          if (lane == 0) *(GAS f32x4*)(ssq + (size_t)m * 4) = (f32x4){s, 0.f, 0.f, 0.f}; } }
}

__device__ __forceinline__ void p_moe_weights(KA a, unsigned char* ws, LAS unsigned char* lds, int i, int gw, int NGW, int wave, int lane) {
    LAS float* scr = (LAS float*)(lds + RING_OFF + wave * 16384);
    constexpr int I_G = 16 * 112, I_D = 56 * 32, PER_E = 2 * I_G + I_D;
    const int l = 2 * i + 1;
    for (int it = gw; it < NE * PER_E; it += NGW) {
        const int e = it / PER_E; int r = it % PER_E;
        if (r < 2 * I_G) { const int sel = r / I_G, q = r % I_G, kb = q / 112, nb = q % 112, n0 = 32 * nb, pn = n0 >> 7, j0 = n0 & 127;
            tr_item(a->in[sel ? I_MU : I_MG] + (size_t)(i * NE + e) * DM * FF, FF, 64 * kb, n0, (bf16*)(ws + WS_WMUP) + (size_t)e * 2 * FF * DM, DM, 256 * pn + 128 * sel + j0, a->in[I_FNW] + l * DM, scr, lane); continue; }
        r -= 2 * I_G;
        { const int kb = r / 32, nb = r % 32;
            tr_item(a->in[I_MD] + (size_t)(i * NE + e) * FF * DM, DM, 64 * kb, 32 * nb, (bf16*)(ws + WS_WMDN) + (size_t)e * DM * FF, FF, 32 * nb, nullptr, scr, lane); }
    }
}

__device__ __forceinline__ void attn_naive_item(int t, int g, const bf16* P, const float* sinks, const float* hnw, bf16* Y, LAS float* sc, int lane) {
    const int s = t & (SEQ - 1); const int nk = (s + 1 < 128) ? (s + 1) : 128;
    { const uint2 raw = *(const uint2*)(P + (size_t)t * INW + g * 256 + lane * 4);
      sc[lane * 4 + 0] = bflo(raw.x); sc[lane * 4 + 1] = bfhi(raw.x); sc[lane * 4 + 2] = bflo(raw.y); sc[lane * 4 + 3] = bfhi(raw.y); }
    LDS_WAIT(); asm volatile("" ::: "memory");
    float d[2][4];
#pragma unroll
    for (int kk = 0; kk < 2; ++kk) {
        const int kidx = lane + 64 * kk;
#pragma unroll
        for (int h = 0; h < 4; ++h) d[kk][h] = 0.f;
        if (kidx < nk) {
            const bf16* kp = P + (size_t)(t - kidx) * INW + COL_K + g * 64;
#pragma unroll
            for (int c = 0; c < 8; ++c) { const uint4 raw = *(const uint4*)(kp + 8 * c);
                const float kf[8] = {bflo(raw.x), bfhi(raw.x), bflo(raw.y), bfhi(raw.y), bflo(raw.z), bfhi(raw.z), bflo(raw.w), bfhi(raw.w)};
#pragma unroll
                for (int h = 0; h < 4; ++h)
#pragma unroll
                    for (int e = 0; e < 8; ++e) d[kk][h] += kf[e] * sc[h * 64 + 8 * c + e]; }
        } else {
#pragma unroll
            for (int h = 0; h < 4; ++h) d[kk][h] = -INFINITY;
        }
    }
    float inv_l[4];
#pragma unroll
    for (int h = 0; h < 4; ++h) {
        const float sk = sinks[4 * g + h] * LOG2E;
        const float m = fmaxf(wave_max(fmaxf(d[0][h], d[1][h])), sk);
        const float p0 = __builtin_amdgcn_exp2f(d[0][h] - m), p1 = __builtin_amdgcn_exp2f(d[1][h] - m);
        const float l = wave_sum(p0 + p1) + __builtin_amdgcn_exp2f(sk - m);
        sc[256 + h * 128 + lane] = p0; sc[256 + h * 128 + 64 + lane] = p1; inv_l[h] = 1.0f / l;
    }
    LDS_WAIT(); asm volatile("" ::: "memory");
    float o[4] = {0.f, 0.f, 0.f, 0.f};
    const bf16* vp = P + (size_t)t * INW + COL_V + g * 64 + lane;
    for (int key = 0; key < nk; ++key) { const float v = bf2f(vp[-(ptrdiff_t)key * INW]);
#pragma unroll
        for (int h = 0; h < 4; ++h) o[h] += sc[256 + h * 128 + key] * v; }
#pragma unroll
    for (int h = 0; h < 4; ++h) { const float ov = o[h] * inv_l[h]; const float ss = wave_sum(ov * ov); const float r = __builtin_amdgcn_rsqf(ss * (1.0f / 64.0f) + EPS);
        const int col = (4 * g + h) * 64 + lane; Y[(size_t)t * DM + col] = (bf16)f2bf(ov * r * hnw[col]); }
    LDS_WAIT(); asm volatile("" ::: "memory");
}
__device__ __forceinline__ void load_u8(const bf16* P, int t, int ch, float* u) {
    const uint4 c = *(const uint4*)(P + (size_t)t * INW + COL_CC + ch); const uint4 h = *(const uint4*)(P + (size_t)t * INW + COL_HC + ch);
    u[0] = bflo(c.x) * bflo(h.x); u[1] = bfhi(c.x) * bfhi(h.x); u[2] = bflo(c.y) * bflo(h.y); u[3] = bfhi(c.y) * bfhi(h.y);
    u[4] = bflo(c.z) * bflo(h.z); u[5] = bfhi(c.z) * bfhi(h.z); u[6] = bflo(c.w) * bflo(h.w); u[7] = bfhi(c.w) * bfhi(h.w);
}
__device__ __forceinline__ void conv_item(int t0, const bf16* P, const float* cw  , const float* hnw  , bf16* Y, int lane) {
    const int ch = 8 * lane; float w0[8], w1[8], w2[8], hw[8], u1[8], u2[8];
#pragma unroll
    for (int i = 0; i < 8; ++i) { w0[i] = cw[ch + i]; w1[i] = cw[512 + ch + i]; w2[i] = cw[1024 + ch + i]; hw[i] = hnw[512 + ch + i]; u1[i] = 0.f; u2[i] = 0.f; }
    if ((t0 & (SEQ - 1)) != 0) { load_u8(P, t0 - 1, ch, u1); load_u8(P, t0 - 2, ch, u2); }
    for (int t = t0; t < t0 + 16; ++t) {
        float u[8]; load_u8(P, t, ch, u);
        const uint4 b = *(const uint4*)(P + (size_t)t * INW + COL_CB + ch);
        const float gb[8] = {bflo(b.x), bfhi(b.x), bflo(b.y), bfhi(b.y), bflo(b.z), bfhi(b.z), bflo(b.w), bfhi(b.w)};
        float o[8]; float ss = 0.f;
#pragma unroll
        for (int i = 0; i < 8; ++i) { o[i] = gb[i] * (w0[i] * u2[i] + w1[i] * u1[i] + w2[i] * u[i]); ss += o[i] * o[i]; }
        ss += __shfl_xor(ss, 1); ss += __shfl_xor(ss, 2); ss += __shfl_xor(ss, 4);
        const float r = __builtin_amdgcn_rsqf(ss * (1.0f / 64.0f) + EPS);
        v4u w; w.x = pk2(o[0] * r * hw[0], o[1] * r * hw[1]); w.y = pk2(o[2] * r * hw[2], o[3] * r * hw[3]); w.z = pk2(o[4] * r * hw[4], o[5] * r * hw[5]); w.w = pk2(o[6] * r * hw[6], o[7] * r * hw[7]);
        *(GAS v4u*)(Y + (size_t)t * DM + 512 + ch) = w;
#pragma unroll
        for (int i = 0; i < 8; ++i) { u2[i] = u1[i]; u1[i] = u[i]; }
    }
}

struct MoeMeta { int cnt[8]; int rowstart[8]; int tend[8]; int ntiles; };
__device__ __forceinline__ MoeMeta moe_meta(gu32* ctl, int i) {
    MoeMeta m; int acc = 0;
#pragma unroll
    for (int e = 0; e < 8; ++e) { m.cnt[e] = (int)__hip_atomic_load(ctl + CW_MOECNT + (i * 8 + e) * 64, RLX_AGENT); m.rowstart[e] = acc * 256; acc += (m.cnt[e] + 255) >> 8; m.tend[e] = acc; }
    m.ntiles = acc; return m;
}
__device__ __forceinline__ void p_router(KA a, unsigned char* ws, LAS unsigned char* lds, gu32* ctl, const float* X, int l, int i, int wave, int lane, int tid, int G) {
    LAS int* lcnt = (LAS int*)(lds + RING_OFF);
    LAS int* ltok = (LAS int*)(lds + RING_OFF + 256);
    const int TPB = (NTOK + G - 1) / G, tb = blockIdx.x * TPB, te = (tb + TPB < NTOK) ? tb + TPB : NTOK;
    if (tid < 16) lcnt[tid] = 0;
    __syncthreads();
    int* tok_e = (int*)(ws + WS_RT); float* tok_g = (float*)(ws + WS_RT + 512 * 1024); float* rstd_o = (float*)(ws + WS_RT + 768 * 1024);
    float w[4][4][8];
    { const float* rw = a->in[I_RW] + (size_t)i * DM * NE; const float* nw = a->in[I_FNW] + l * DM;
#pragma unroll
      for (int j = 0; j < 4; ++j)
#pragma unroll
          for (int c = 0; c < 4; ++c) { const int d = 4 * lane + 256 * j + c; const float n = nw[d]; const f32x4 r0 = *(const f32x4*)(rw + d * 8), r1 = *(const f32x4*)(rw + d * 8 + 4);
              w[j][c][0] = r0.x * n; w[j][c][1] = r0.y * n; w[j][c][2] = r0.z * n; w[j][c][3] = r0.w * n; w[j][c][4] = r1.x * n; w[j][c][5] = r1.y * n; w[j][c][6] = r1.z * n; w[j][c][7] = r1.w * n; } }
    for (int t = tb + wave; t < te; t += NWAVES) {
        const GAS f32x4* xr = (const GAS f32x4*)(X + (size_t)t * DM) + lane; float s = 0.f; float lg[8] = {0.f, 0.f, 0.f, 0.f, 0.f, 0.f, 0.f, 0.f};
#pragma unroll
        for (int j = 0; j < 4; ++j) { const f32x4 v = xr[64 * j]; s += (v.x * v.x + v.y * v.y) + (v.z * v.z + v.w * v.w);
#pragma unroll
            for (int e = 0; e < 8; ++e) lg[e] += (v.x * w[j][0][e] + v.y * w[j][1][e]) + (v.z * w[j][2][e] + v.w * w[j][3][e]); }
        s = wave_sum(s); const float rstd = 1.0f / sqrtf(s * (1.0f / DM) + EPS);
#pragma unroll
        for (int e = 0; e < 8; ++e) lg[e] = wave_sum(lg[e]) * rstd;
        int e0 = 0; float l0 = lg[0];
#pragma unroll
        for (int e = 1; e < 8; ++e) if (lg[e] > l0) { l0 = lg[e]; e0 = e; }
        int e1 = -1; float l1 = -INFINITY;
#pragma unroll
        for (int e = 0; e < 8; ++e) if (e != e0 && lg[e] > l1) { l1 = lg[e]; e1 = e; }
        const float ex = __expf(l1 - l0), g0 = 1.0f / (1.0f + ex), g1 = ex * g0;
        if (lane == 0) {
            const int r0 = __hip_atomic_fetch_add(lcnt + e0, 1, __ATOMIC_RELAXED, __HIP_MEMORY_SCOPE_WORKGROUP), r1 = __hip_atomic_fetch_add(lcnt + e1, 1, __ATOMIC_RELAXED, __HIP_MEMORY_SCOPE_WORKGROUP);
            const int tl = t - tb; ltok[tl * 4 + 0] = e0; ltok[tl * 4 + 1] = e1; ltok[tl * 4 + 2] = r0; ltok[tl * 4 + 3] = r1;
            tok_e[t * 2 + 0] = e0; tok_e[t * 2 + 1] = e1; tok_g[t * 2 + 0] = g0; tok_g[t * 2 + 1] = g1; rstd_o[t] = rstd;
        }
    }
    __syncthreads();
    if (tid < 8) lcnt[8 + tid] = (int)__hip_atomic_fetch_add(ctl + CW_MOECNT + (i * 8 + tid) * 64, (unsigned)lcnt[tid], RLX_AGENT);
    __syncthreads();
    int* tok_pos = (int*)(ws + WS_RT + 256 * 1024); int* list = (int*)(ws + WS_LIST);
    for (int tl = tid; tl < te - tb; tl += NWAVES * 64) {
#pragma unroll
        for (int k = 0; k < 2; ++k) { const int e = ltok[tl * 4 + k], pos = lcnt[8 + e] + ltok[tl * 4 + 2 + k]; list[(size_t)e * NTOK + pos] = tb + tl; tok_pos[(tb + tl) * 2 + k] = pos; }
    }
    __syncthreads();
}
__device__ __forceinline__ void p_gather(unsigned char* ws, gu32* ctl, const float* X, int i, int gw, int NGW, int lane) {
    const MoeMeta mm = moe_meta(ctl, i);
    const int* list = (const int*)(ws + WS_LIST); const float* rstd_o = (const float*)(ws + WS_RT + 768 * 1024); bf16* xs = (bf16*)(ws + WS_YS);
    const int nrows = mm.ntiles * 256;
    for (int r = gw; r < nrows; r += NGW) {
        int e = 0;
#pragma unroll
        for (int j = 0; j < 7; ++j) e += (r >= mm.tend[j] * 256) ? 1 : 0;
        int rs0 = 0, ce = 0;
#pragma unroll
        for (int j = 0; j < 8; ++j) { if (j == e) { rs0 = mm.rowstart[j]; ce = mm.cnt[j]; } }
        const int p = r - rs0;
        GAS unsigned long long* o8 = (GAS unsigned long long*)(xs + (size_t)r * DM) + lane;
        if (p < ce) {
            const int tok = list[(size_t)e * NTOK + p]; const float rs = rstd_o[tok];
            const GAS f32x4* xr = (const GAS f32x4*)(X + (size_t)tok * DM) + lane;
#pragma unroll
            for (int j = 0; j < 4; ++j) { const f32x4 v = xr[64 * j]; o8[64 * j] = (unsigned long long)pk2(v.x * rs, v.y * rs) | ((unsigned long long)pk2(v.z * rs, v.w * rs) << 32); }
        } else {
#pragma unroll
            for (int j = 0; j < 4; ++j) o8[64 * j] = 0ull;
        }
    }
}
__device__ __forceinline__ void p_combine(KA a, unsigned char* ws, gu32* ctl, float* X, int i, bool last, int gw, int NGW, int lane) {
    const MoeMeta mm = moe_meta(ctl, i);
    const int* tok_e = (const int*)(ws + WS_RT); const int* tok_pos = (const int*)(ws + WS_RT + 256 * 1024); const float* tok_g = (const float*)(ws + WS_RT + 512 * 1024);
    const bf16* ys = (const bf16*)(ws + WS_YS); bf16* xb = (bf16*)(ws + WS_XB); float* ssq = (float*)(ws + WS_SSQ); const float* fw = a->in[I_FINW];
    for (int t = gw; t < NTOK; t += NGW) {
        int row[2]; float g[2];
#pragma unroll
        for (int k = 0; k < 2; ++k) { const int e = tok_e[t * 2 + k]; int rs0 = 0;
#pragma unroll
            for (int j = 0; j < 8; ++j) if (j == e) rs0 = mm.rowstart[j];
            row[k] = rs0 + tok_pos[t * 2 + k]; g[k] = tok_g[t * 2 + k]; }
        GAS f32x4* xr = (GAS f32x4*)(X + (size_t)t * DM) + lane;
        const GAS v2u* y0 = (const GAS v2u*)(ys + (size_t)row[0] * DM) + lane; const GAS v2u* y1 = (const GAS v2u*)(ys + (size_t)row[1] * DM) + lane;
        f32x4 v[4]; float s = 0.f;
#pragma unroll
        for (int j = 0; j < 4; ++j) { const f32x4 x = xr[64 * j]; const v2u p = y0[64 * j], q = y1[64 * j];
            v[j].x = x.x + (g[0] * bflo(p.x) + g[1] * bflo(q.x)); v[j].y = x.y + (g[0] * bfhi(p.x) + g[1] * bfhi(q.x));
            v[j].z = x.z + (g[0] * bflo(p.y) + g[1] * bflo(q.y)); v[j].w = x.w + (g[0] * bfhi(p.y) + g[1] * bfhi(q.y));
            s += (v[j].x * v[j].x + v[j].y * v[j].y) + (v[j].z * v[j].z + v[j].w * v[j].w); }
        s = wave_sum(s);
        if (last) {
            const float r = 1.0f / sqrtf(s * (1.0f / DM) + EPS);
#pragma unroll
            for (int j = 0; j < 4; ++j) { const f32x4 wv = *((const GAS f32x4*)fw + lane + 64 * j); xr[64 * j] = (f32x4){v[j].x * r * wv.x, v[j].y * r * wv.y, v[j].z * r * wv.z, v[j].w * r * wv.w}; }
        } else {
            GAS unsigned long long* o8 = (GAS unsigned long long*)(xb + (size_t)t * DM) + lane;
#pragma unroll
            for (int j = 0; j < 4; ++j) { xr[64 * j] = v[j]; o8[64 * j] = (unsigned long long)pk2(v[j].x, v[j].y) | ((unsigned long long)pk2(v[j].z, v[j].w) << 32); }
            if (lane == 0) *(GAS f32x4*)(ssq + (size_t)t * 4) = (f32x4){s, 0.f, 0.f, 0.f};
        }
    }
}

#define PHASE_ENV() KA ap = ap0; unsigned char* ws = ws0; int l = l0, G = G0, bx = bx0; asm volatile("" : "+s"(ap), "+s"(ws), "+s"(l), "+s"(G), "+s"(bx)); int tid = tid0, lane = lane0, wave = wave0, gw = gw0, NGW = NGW0; asm volatile("" : "+v"(tid), "+v"(lane), "+s"(wave), "+s"(gw), "+s"(NGW)); (void)tid; (void)lane; (void)wave; (void)gw; (void)NGW; gu32* ctl = (gu32*)(ws + WS_CTL); (void)ctl; (void)l; (void)G; (void)bx
__global__ void __launch_bounds__(NWAVES * 64, 2) fwd_kernel(Args args) {
    extern __shared__ __attribute__((aligned(16))) unsigned char lds_raw[];
    LAS unsigned char* lds = (LAS unsigned char*)lds_raw;
    volatile LAS unsigned* MISC = (volatile LAS unsigned*)(lds + MISC_OFF);
    const int tid0 = threadIdx.x, lane0 = tid0 & 63, wave0 = __builtin_amdgcn_readfirstlane(tid0 >> 6);
    const int G0 = gridDim.x; const int bx0 = blockIdx.x;
    const int vcu = (G0 % 8 == 0) ? (bx0 % 8) * (G0 / 8) + bx0 / 8 : bx0;
    const int gw0 = vcu * NWAVES + wave0, NGW0 = G0 * NWAVES;
    const KA ap0 = (KA)__builtin_amdgcn_kernarg_segment_ptr();
    unsigned char* const ws0 = ap0->ws;
    for (int u = tid0; u < (LDS_BYTES - LDSCTL_OFF) / 4; u += NWAVES * 64) ((LAS unsigned*)(lds + LDSCTL_OFF))[u] = 0u;
    __syncthreads();
    const int lo = ap0->ph_lo, hi = ap0->ph_hi;
    XcdBarrier bar; bar.bar = (unsigned*)(ws0 + WS_CTL) + CW_BAR; bar.x = 0; bar.st = nullptr;
    if (hi - lo > 1) bar = xcd_barrier_post((unsigned*)(ws0 + WS_CTL) + CW_BAR, MISC + 8);
#define PH(p) (lo <= (p) && (p) < hi)
#define SEAM(p) do { if ((p) + 1 < hi) { XcdBarrier b_ = bar; asm volatile("" : "+s"(b_.bar), "+s"(b_.x)); xcd_barrier(b_); } } while (0)
    int pid = 0;
    if (PH(pid)) { const int l0 = 0; PHASE_ENV(); p_prologue(ap, ws, lds, gw, NGW, wave, lane, bx * (NWAVES * 64) + tid, G * NWAVES * 64); SEAM(pid); }
    ++pid;
    for (int l0 = 0; l0 < DEPTH; ++l0) {
        if (PH(pid)) { PHASE_ENV();
            pg8::Gemm g{(const bf16*)(ws + WS_XB), (const bf16*)(ws + WS_WIN) + (size_t)l * INW * DM, NTOK, INW, DM, 0};
            pg8::StaticOrder S; S.init(NTOK, INW, G, bx);
            pg8::EpiIn E{(bf16*)(ws + WS_PROJ), (const float*)(ws + WS_SSQ), (const float*)(ws + WS_ROPEC), (const float*)(ws + WS_ROPES), QSCALE};
            pg8::gemm_phase<pg8::EpiIn, pg8::StaticOrder, true, true>(lds + RING_OFF, g, S, E);
            SEAM(pid);
        }
        ++pid;
        if (PH(pid)) { PHASE_ENV();
            const float* sinks = ap->in[I_SINK] + l * 8; const float* hnw = ap->in[I_HNW] + l * DM; const float* cw = ap->in[I_CONVW] + l * 3 * 512;
            const bf16* PROJ = (const bf16*)(ws + WS_PROJ); bf16* Y = (bf16*)(ws + WS_Y);
            LAS float* sc = (LAS float*)(lds + RING_OFF + wave * 4096);
            for (int it = gw; it < NTOK * 2; it += NGW) attn_naive_item(it >> 1, it & 1, PROJ, sinks, hnw, Y, sc, lane);
            for (int it = gw; it < NTOK / 16; it += NGW) conv_item(it * 16, PROJ, cw, hnw, Y, lane);
            SEAM(pid);
        }
        ++pid;
        if (PH(pid)) { PHASE_ENV();
            pg8::Gemm g{(const bf16*)(ws + WS_Y), (const bf16*)(ws + WS_WOUT) + (size_t)l * DM * DM, NTOK, DM, DM, 0};
            pg8::StaticOrder S; S.init(NTOK, DM, G, bx);
            float* X = ap->out;
            pg8::EpiRes E{l == 0 ? ap->in[I_X] : X, X, (bf16*)(ws + WS_XB), (float*)(ws + WS_SSQ), (PG8_LAS float*)(lds + SSQT_OFF)};
            pg8::gemm_phase<pg8::EpiRes, pg8::StaticOrder, true, true>(lds + RING_OFF, g, S, E);
            SEAM(pid);
        }
        ++pid;
        if ((l0 & 1) == 0) {
            if (PH(pid)) { PHASE_ENV(); const int i = l >> 1;
                pg8::Gemm g{(const bf16*)(ws + WS_XB), (const bf16*)(ws + WS_WDUP) + (size_t)i * 2 * FF * DM, NTOK, 2 * FF, DM, 0};
                pg8::StaticOrder S; S.init(NTOK, 2 * FF, G, bx);
                pg8::EpiUp E{(bf16*)(ws + WS_ACT), FF, (const float*)(ws + WS_SSQ)};
                pg8::gemm_phase<pg8::EpiUp, pg8::StaticOrder, true, true>(lds + RING_OFF, g, S, E);
                SEAM(pid);
            }
            ++pid;
            if (PH(pid)) { PHASE_ENV(); const int i = l >> 1;
                pg8::Gemm g{(const bf16*)(ws + WS_ACT), (const bf16*)(ws + WS_WDDN) + (size_t)i * DM * FF, NTOK, DM, FF, 0};
                pg8::StaticOrder S; S.init(NTOK, DM, G, bx);
                float* X = ap->out;
                pg8::EpiRes E{X, X, (bf16*)(ws + WS_XB), (float*)(ws + WS_SSQ), (PG8_LAS float*)(lds + SSQT_OFF)};
                pg8::gemm_phase<pg8::EpiRes, pg8::StaticOrder, true, true>(lds + RING_OFF, g, S, E);
                SEAM(pid);
            }
            ++pid;
        } else {
            if (PH(pid)) { PHASE_ENV(); const int i = l >> 1;
                p_router(ap, ws, lds, ctl, ap->out, l, i, wave, lane, tid, G);
                p_moe_weights(ap, ws, lds, i, gw, NGW, wave, lane);
                SEAM(pid);
            }
            ++pid;
            if (PH(pid)) { PHASE_ENV(); const int i = l >> 1; p_gather(ws, ctl, ap->out, i, gw, NGW, lane); SEAM(pid); }
            ++pid;
            if (PH(pid)) { PHASE_ENV(); const int i = l >> 1;
                const MoeMeta mm = moe_meta(ctl, i);
                pg8::Gemm g{(const bf16*)(ws + WS_YS), (const bf16*)(ws + WS_WMUP), mm.ntiles * 256, 2 * FF, DM, (size_t)2 * FF * DM * 2};
                pg8::MoeOrder S; S.init(mm.ntiles * 256, 2 * FF, G, bx);
#pragma unroll
                for (int e = 0; e < 8; ++e) S.tend[e] = mm.tend[e];
                pg8::EpiUp E{(bf16*)(ws + WS_ACT), FF, nullptr};
                pg8::gemm_phase<pg8::EpiUp, pg8::MoeOrder, true, true>(lds + RING_OFF, g, S, E);
                SEAM(pid);
            }
            ++pid;
            if (PH(pid)) { PHASE_ENV(); const int i = l >> 1;
                const MoeMeta mm = moe_meta(ctl, i);
                pg8::Gemm g{(const bf16*)(ws + WS_ACT), (const bf16*)(ws + WS_WMDN), mm.ntiles * 256, DM, FF, (size_t)DM * FF * 2};
                pg8::MoeOrder S; S.init(mm.ntiles * 256, DM, G, bx);
#pragma unroll
                for (int e = 0; e < 8; ++e) S.tend[e] = mm.tend[e];
                pg8::EpiYs E{(bf16*)(ws + WS_YS), DM};
                pg8::gemm_phase<pg8::EpiYs, pg8::MoeOrder, true, true>(lds + RING_OFF, g, S, E);
                SEAM(pid);
            }
            ++pid;
            if (PH(pid)) { PHASE_ENV(); const int i = l >> 1; p_combine(ap, ws, ctl, ap->out, i, l == DEPTH - 1, gw, NGW, lane); SEAM(pid); }
            ++pid;
        }
    }
#undef PH
#undef SEAM
}
constexpr int N_PHASES = 1 + 2 * (3 + 2) + 2 * (3 + 5);

extern "C" void kernel_launch(void* const* d_in, const int* in_sizes, int n_in, void* d_out, int out_size, void* d_ws, size_t ws_size, hipStream_t stream) {
    static int grid = 0;
    if (grid == 0) {
        if (n_in != 17 || out_size != NTOK * DM || ws_size < WS_END) { fprintf(stderr, "kernel_launch: unexpected shapes (n_in %d, out %d, ws %zu < %zu); nothing launched\n", n_in, out_size, ws_size, (size_t)WS_END); grid = -1; return; }
        int dev = 0, cus = 0, per_cu = 0;
        if (hipGetDevice(&dev) != hipSuccess || hipDeviceGetAttribute(&cus, hipDeviceAttributeMultiprocessorCount, dev) != hipSuccess) { grid = -1; return; }
        if (hipFuncSetAttribute((const void*)fwd_kernel, hipFuncAttributeMaxDynamicSharedMemorySize, LDS_BYTES) != hipSuccess) { fprintf(stderr, "kernel_launch: hipFuncSetAttribute failed\n"); grid = -1; return; }
        if (hipOccupancyMaxActiveBlocksPerMultiprocessor(&per_cu, (const void*)fwd_kernel, NWAVES * 64, LDS_BYTES) != hipSuccess || per_cu < 1) fprintf(stderr, "kernel_launch: occupancy query reports %d blocks per CU\n", per_cu);
        (void)hipGetLastError();
        grid = cus;
    }
    if (grid < 0) return;
    if (hipMemsetAsync((char*)d_ws + WS_CTL, 0, CTL_ZERO_BYTES, stream) != hipSuccess) return;
    Args a{};
    for (int i = 0; i < 17; ++i) a.in[i] = (const float*)d_in[i];
    a.out = (float*)d_out; a.ws = (unsigned char*)d_ws;
#if MK_PER_PHASE
    for (int p = 0; p < N_PHASES; ++p) { a.ph_lo = p; a.ph_hi = p + 1; hipLaunchKernelGGL(fwd_kernel, dim3(grid), dim3(NWAVES * 64), LDS_BYTES, stream, a); }
#else
    a.ph_lo = 0; a.ph_hi = N_PHASES;
    hipLaunchKernelGGL(fwd_kernel, dim3(grid), dim3(NWAVES * 64), LDS_BYTES, stream, a);
#endif
}
```

```cpp
#include <hip/hip_runtime.h>
#include <cstdio>
#include <cstdint>
#include <cstddef>
namespace pg8 {
#define PG8_LAS __attribute__((address_space(3)))
typedef unsigned short bf16_t;
typedef short bf16x8 __attribute__((ext_vector_type(8)));
typedef float f32x4 __attribute__((ext_vector_type(4)));
typedef unsigned u32x4 __attribute__((ext_vector_type(4)));
constexpr int BM = 256, BK = 64, HALF = 128, HTB = HALF * BK * 2  , STAGE_BYTES = 8 * HTB, NXCD = 8, WGM = 8;

__host__ __device__ __forceinline__ int lds_byte(int r, int c) { const int st = (r >> 4) * 2 + (c >> 5), rr = r & 15, cc = c & 31, ob = rr * 64 + cc * 2; return st * 1024 + (ob ^ (((ob >> 9) & 1) << 5)); }
__host__ __device__ __forceinline__ void stage_rc(int b, int& R, int& C) { const int st = b / 1024, sb = b % 1024, swz = sb ^ (((sb >> 9) & 1) << 5); R = (st >> 1) * 16 + swz / 64; C = (st & 1) * 32 + (swz % 64) / 2; }
__host__ __device__ __forceinline__ int perm32(int rho) { const int n = rho >> 4, i = rho & 15; return 8 * (i >> 2) + 4 * n + (i & 3); }

struct Unit { int pm, pn, pe, pa; };
struct Gemm { const bf16_t* A; const bf16_t* Bt; int M, N, K; size_t estep; };

struct StaticOrder {
    int nM, nN, nwg, G, c;
    __host__ __device__ void init(int M, int N, int G_, int c_) { nM = M / BM; nN = N / BM; nwg = nM * nN; G = G_; c = c_; }
    __host__ __device__ bool next(int i, Unit& u) const {
        const long L = (long)i * G + c; if (L >= nwg) return false;
        int wgid = (int)L; { const int q = nwg / NXCD, r = nwg % NXCD, xcd = wgid % NXCD, off = wgid / NXCD; wgid = (xcd < r ? xcd * (q + 1) : r * (q + 1) + (xcd - r) * q) + off; }
        const int nig = WGM * nN, gid = wgid / nig, fm = gid * WGM, gsz = (nM - fm) < WGM ? (nM - fm) : WGM;
        u.pm = fm + ((wgid % nig) % gsz); u.pn = (wgid % nig) / gsz; u.pe = 0; u.pa = u.pm; return true;
    }
    __device__ __forceinline__ void a_ready(const Unit&) const {}
    __device__ __forceinline__ void done(const Unit&) const {}
};

__device__ __forceinline__ unsigned cvt_pk_bf16(float lo, float hi) { unsigned r; asm volatile("v_cvt_pk_bf16_f32 %0, %1, %2" : "=v"(r) : "v"(lo), "v"(hi)); return r; }
typedef float f32x2 __attribute__((ext_vector_type(2)));

typedef unsigned u32x2 __attribute__((ext_vector_type(2)));
constexpr float NORM_EPS = 1e-5f;
__device__ __forceinline__ float row_rstd(const float* ssq, int row) {
    const f32x4 s = *(const f32x4*)(ssq + (size_t)row * 4);
    return __builtin_amdgcn_rsqf(((s[0] + s[1]) + (s[2] + s[3])) * (1.0f / 1024.0f) + NORM_EPS);
}
__device__ __forceinline__ float silu_mul(float g, float u) {
    const float e = __builtin_amdgcn_exp2f(-1.4426950408889634f * g);
    return g * u * __builtin_amdgcn_rcpf(1.0f + e);
}
__device__ __forceinline__ float h_lo(unsigned w) { return (float)__builtin_bit_cast(_Float16, (unsigned short)(w & 0xffffu)); }
__device__ __forceinline__ float h_hi(unsigned w) { return (float)__builtin_bit_cast(_Float16, (unsigned short)(w >> 16)); }
struct EpiIn {
    static constexpr bool PERM = true, AFTER_DRAIN = false; static constexpr int NST = 0;
    bf16_t* P; const float* ssq; const unsigned* rcs; float qscale;
    __device__ __forceinline__ void operator()(const f32x4 (&acc)[2][2][4][2], const Unit& u, int wr, int wc, int fr, int fq) const {
        const int row0 = u.pm * BM + wr * 64 + fr;
        const int colb = u.pn * BM + wc * 64 + 8 * fq;
        const bool rope = (u.pn < 2) || (u.pn == 2 && wc < 2);
        const float sc = (u.pn < 2) ? qscale : 1.0f;
        u32x4 cs[4][2], wo[4], vo[4]; f32x4 sv[4];
#pragma unroll
        for (int ai = 0; ai < 2; ++ai) {
#pragma unroll
            for (int m = 0; m < 4; ++m) sv[m] = *(const f32x4*)(ssq + (size_t)(row0 + ai * HALF + m * 16) * 4);
            if (rope) {
#pragma unroll
                for (int m = 0; m < 4; ++m) { const unsigned* cp = rcs + (size_t)(row0 + ai * HALF + m * 16) * 32 + 8 * fq; cs[m][0] = *(const u32x4*)cp; cs[m][1] = *(const u32x4*)(cp + 4); }
            }
            if (ai == 1) {
#pragma unroll
                for (int m = 0; m < 4; ++m) { bf16_t* rp = P + (size_t)(row0 + m * 16) * 2304 + colb; *(u32x4*)rp = wo[m]; *(u32x4*)(rp + 32) = vo[m]; }
            }
#pragma unroll
            for (int m = 0; m < 4; ++m) {
                const float rs = __builtin_amdgcn_rsqf(((sv[m][0] + sv[m][1]) + (sv[m][2] + sv[m][3])) * (1.0f / 1024.0f) + NORM_EPS);
                f32x4 a0 = acc[ai][0][m][0] * rs, a1 = acc[ai][0][m][1] * rs, b0 = acc[ai][1][m][0] * rs, b1 = acc[ai][1][m][1] * rs;
                if (rope) {
                    const u32x4 q0 = cs[m][0], q1 = cs[m][1];
                    const f32x4 c0 = {h_lo(q0.x), h_lo(q0.y), h_lo(q0.z), h_lo(q0.w)}, s0 = {h_hi(q0.x), h_hi(q0.y), h_hi(q0.z), h_hi(q0.w)};
                    const f32x4 c1 = {h_lo(q1.x), h_lo(q1.y), h_lo(q1.z), h_lo(q1.w)}, s1 = {h_hi(q1.x), h_hi(q1.y), h_hi(q1.z), h_hi(q1.w)};
                    const f32x4 o0 = (a0 * c0 - b0 * s0) * sc, o1 = (a1 * c1 - b1 * s1) * sc, p0 = (b0 * c0 + a0 * s0) * sc, p1 = (b1 * c1 + a1 * s1) * sc;
                    a0 = o0; a1 = o1; b0 = p0; b1 = p1;
                }
                u32x4 w; w.x = cvt_pk_bf16(a0[0], a0[1]); w.y = cvt_pk_bf16(a0[2], a0[3]); w.z = cvt_pk_bf16(a1[0], a1[1]); w.w = cvt_pk_bf16(a1[2], a1[3]);
                u32x4 v; v.x = cvt_pk_bf16(b0[0], b0[1]); v.y = cvt_pk_bf16(b0[2], b0[3]); v.z = cvt_pk_bf16(b1[0], b1[1]); v.w = cvt_pk_bf16(b1[2], b1[3]);
                wo[m] = w; vo[m] = v;
            }
        }
#pragma unroll
        for (int m = 0; m < 4; ++m) { bf16_t* rp = P + (size_t)(row0 + HALF + m * 16) * 2304 + colb; *(u32x4*)rp = wo[m]; *(u32x4*)(rp + 32) = vo[m]; }
    }
};
__device__ __forceinline__ unsigned pk4_fp8(float a, float b, float c, float d) {
    unsigned w; asm("v_cvt_pk_fp8_f32 %0, %1, %2" : "=v"(w) : "v"(a), "v"(b)); asm("v_cvt_pk_fp8_f32 %0, %1, %2 op_sel:[0,0,1]" : "+v"(w) : "v"(c), "v"(d)); return w;
}
__device__ __forceinline__ float bf_lo(unsigned w) { return __builtin_bit_cast(float, w << 16); }
__device__ __forceinline__ float bf_hi(unsigned w) { return __builtin_bit_cast(float, w & 0xffff0000u); }
struct EpiRes {
    static constexpr bool PERM = true, AFTER_DRAIN = false; static constexpr int NST = 0;
    bf16_t* XB; unsigned char* XF; float* ssq; PG8_LAS float* tbl; float cs, fs;
    __device__ __forceinline__ void operator()(const f32x4 (&acc)[2][2][4][2], const Unit& u, int wr, int wc, int fr, int fq) const {
        const int col0 = u.pn * BM + wc * 32 + 8 * fq;
        u32x4 rin[2][4][2];
#pragma unroll
        for (int ai = 0; ai < 2; ++ai)
#pragma unroll
            for (int m = 0; m < 4; ++m)
#pragma unroll
                for (int bj = 0; bj < 2; ++bj) rin[ai][m][bj] = *(const u32x4*)(XB + (size_t)(u.pm * BM + ai * HALF + wr * 64 + m * 16 + fr) * 1024 + col0 + bj * HALF);
#pragma unroll
        for (int ai = 0; ai < 2; ++ai)
#pragma unroll
            for (int m = 0; m < 4; ++m) {
                const int rowl = ai * HALF + wr * 64 + m * 16 + fr; const size_t off = (size_t)(u.pm * BM + rowl) * 1024 + col0; float sq = 0.f;
#pragma unroll
                for (int bj = 0; bj < 2; ++bj) {
                    const size_t o = off + bj * HALF;
                    const u32x4 rw = rin[ai][m][bj];
                    const f32x4 r0 = {bf_lo(rw.x), bf_hi(rw.x), bf_lo(rw.y), bf_hi(rw.y)}, r1 = {bf_lo(rw.z), bf_hi(rw.z), bf_lo(rw.w), bf_hi(rw.w)};
                    const f32x4 x0 = r0 + acc[ai][bj][m][0] * cs, x1 = r1 + acc[ai][bj][m][1] * cs;
                    { u32x4 w; w.x = cvt_pk_bf16(x0[0], x0[1]); w.y = cvt_pk_bf16(x0[2], x0[3]); w.z = cvt_pk_bf16(x1[0], x1[1]); w.w = cvt_pk_bf16(x1[2], x1[3]); *(u32x4*)(XB + o) = w; }
                    if (XF) { u32x2 w; w.x = pk4_fp8(x0[0] * fs, x0[1] * fs, x0[2] * fs, x0[3] * fs); w.y = pk4_fp8(x1[0] * fs, x1[1] * fs, x1[2] * fs, x1[3] * fs); *(u32x2*)(XF + o) = w; }
                    sq += ((x0[0] * x0[0] + x0[1] * x0[1]) + (x0[2] * x0[2] + x0[3] * x0[3])) + ((x1[0] * x1[0] + x1[1] * x1[1]) + (x1[2] * x1[2] + x1[3] * x1[3]));
                }
                sq += __shfl_xor(sq, 16); sq += __shfl_xor(sq, 32);
                if (fq == 0) tbl[rowl * 4 + wc] = sq;
            }
        asm volatile("s_waitcnt lgkmcnt(0)" ::: "memory"); __builtin_amdgcn_s_barrier(); asm volatile("" ::: "memory");
        const int lane = fq * 16 + fr;
        if (lane < 32) {
            const int rowl = (wc >> 1) * HALF + wr * 64 + (wc & 1) * 32 + lane;
            const f32x4 t = *(const PG8_LAS f32x4*)(tbl + rowl * 4);
            ssq[(size_t)(u.pm * BM + rowl) * 4 + u.pn] = (t[0] + t[1]) + (t[2] + t[3]);
        }
    }
};
template <bool F8OUT> struct EpiUp {
    static constexpr bool PERM = true, AFTER_DRAIN = false; static constexpr int NST = 8;
    void* O; int ldc; const float* ssq; float cs, fs;
    static __device__ __forceinline__ float sm(float ag, float au, float k1, float ik2) { return (ag * au) * __builtin_amdgcn_rcpf(__builtin_fmaf(__builtin_amdgcn_exp2f(ag * k1), ik2, ik2)); }
    typedef float v2f __attribute__((ext_vector_type(2)));
    static __device__ __forceinline__ v2f sm2(v2f ag, v2f au, float k1, float ik2) {
        const v2f K1 = {k1, k1}, K2 = {ik2, ik2}; const v2f t = ag * K1; v2f e; e.x = __builtin_amdgcn_exp2f(t.x); e.y = __builtin_amdgcn_exp2f(t.y);
        const v2f d = __builtin_elementwise_fma(e, K2, K2); v2f r; r.x = __builtin_amdgcn_rcpf(d.x); r.y = __builtin_amdgcn_rcpf(d.y); return (ag * au) * r; }
    static __device__ __forceinline__ v2f lo2(f32x4 v) { return __builtin_shufflevector(v, v, 0, 1); }
    static __device__ __forceinline__ v2f hi2(f32x4 v) { return __builtin_shufflevector(v, v, 2, 3); }
    __device__ __forceinline__ void operator()(const f32x4 (&acc)[2][2][4][2], const Unit& u, int wr, int wc, int fr, int fq) const {
        const int row0 = u.pm * BM + wr * 64 + fr, col0 = u.pn * HALF + wc * 32 + 8 * fq;
        float rsv[2][4];
#pragma unroll
        for (int ai = 0; ai < 2; ++ai)
#pragma unroll
            for (int m = 0; m < 4; ++m) rsv[ai][m] = ssq ? row_rstd(ssq, row0 + ai * HALF + m * 16) : 1.0f;
#pragma unroll
        for (int ai = 0; ai < 2; ++ai)
#pragma unroll
            for (int m = 0; m < 4; ++m) {
                const int row = row0 + ai * HALF + m * 16;
                const float rs = rsv[ai][m] * cs, k1 = -1.4426950408889634f * rs, k2 = __builtin_amdgcn_rcpf(rs * rs * (F8OUT ? fs : 1.0f));
                const f32x4 g0 = acc[ai][0][m][0], g1 = acc[ai][0][m][1], u0 = acc[ai][1][m][0], u1 = acc[ai][1][m][1];
                if (F8OUT) {
                    const v2f a0 = sm2(lo2(g0), lo2(u0), k1, k2), a1 = sm2(hi2(g0), hi2(u0), k1, k2), a2 = sm2(lo2(g1), lo2(u1), k1, k2), a3 = sm2(hi2(g1), hi2(u1), k1, k2);
                    u32x2 w; w.x = pk4_fp8(a0.x, a0.y, a1.x, a1.y); w.y = pk4_fp8(a2.x, a2.y, a3.x, a3.y);
                    *(u32x2*)((unsigned char*)O + (size_t)row * ldc + col0) = w;
                } else {
                    u32x4 w;
                    const v2f a0 = sm2(lo2(g0), lo2(u0), k1, k2), a1 = sm2(hi2(g0), hi2(u0), k1, k2), a2 = sm2(lo2(g1), lo2(u1), k1, k2), a3 = sm2(hi2(g1), hi2(u1), k1, k2);
                    w.x = cvt_pk_bf16(a0.x, a0.y); w.y = cvt_pk_bf16(a1.x, a1.y); w.z = cvt_pk_bf16(a2.x, a2.y); w.w = cvt_pk_bf16(a3.x, a3.y);
                    *(u32x4*)((bf16_t*)O + (size_t)row * ldc + col0) = w;
                }
            }
    }
};
struct EpiYs {
    static constexpr bool PERM = true, AFTER_DRAIN = false; static constexpr int NST = 16;
    unsigned char* O; int ldc; float cs;
    __device__ __forceinline__ void operator()(const f32x4 (&acc)[2][2][4][2], const Unit& u, int wr, int wc, int fr, int fq) const {
        const int row0 = u.pm * BM + wr * 64 + fr, col0 = u.pn * BM + wc * 32 + 8 * fq;
#pragma unroll
        for (int ai = 0; ai < 2; ++ai)
#pragma unroll
            for (int m = 0; m < 4; ++m) { unsigned char* rowp = O + (size_t)(row0 + ai * HALF + m * 16) * ldc + col0;
#pragma unroll
                for (int bj = 0; bj < 2; ++bj) { const f32x4 v0 = acc[ai][bj][m][0] * cs, v1 = acc[ai][bj][m][1] * cs;
                    u32x2 w; w.x = pk4_fp8(v0[0], v0[1], v0[2], v0[3]); w.y = pk4_fp8(v1[0], v1[1], v1[2], v1[3]);
                    *(u32x2*)(rowp + bj * HALF) = w; } }
    }
};
struct MoeOrder : StaticOrder {
    int tend[8]; int acap;
    __device__ __forceinline__ bool next(int i, Unit& u) const {
        if (!StaticOrder::next(i, u)) return false;
        int e = 0, ts = 0;
#pragma unroll
        for (int j = 0; j < 7; ++j) { const bool ge = u.pm >= tend[j]; e += ge ? 1 : 0; ts = ge ? tend[j] : ts; }
        u.pe = __builtin_amdgcn_readfirstlane(e); u.pm = __builtin_amdgcn_readfirstlane(u.pm); u.pn = __builtin_amdgcn_readfirstlane(u.pn);
        u.pa = acap ? __builtin_amdgcn_readfirstlane(e * acap + (u.pm - ts)) : u.pm; return true;
    }
};

__device__ __forceinline__ void pg8_glds(const char* sbase, unsigned voff, unsigned lds_dst) {
    unsigned keep; asm volatile("s_mov_b32 %0, m0\n\ts_mov_b32 m0, %3\n\ts_nop 2\n\tglobal_load_lds_dwordx4 %1, %2\n\ts_mov_b32 m0, %0" : "=&s"(keep) : "v"(voff), "s"(sbase), "s"(lds_dst) : "memory"); }
#ifndef PG8_OPT_Z
#define PG8_OPT_Z 1
#endif
#ifndef PG8_OPT_NEXT
#define PG8_OPT_NEXT 1
#endif
template <int N> __device__ __forceinline__ void pg8_waitv() { asm volatile("s_waitcnt vmcnt(%0)" :: "n"(N) : "memory"); }
template <class Epi, class Sched, bool ALIGN_EPI = false, bool SP2 = false, bool F8 = false>
__device__ __forceinline__ void gemm_phase(PG8_LAS unsigned char* lds, const Gemm g, const Sched& S, const Epi& E) {
    int tid_ = threadIdx.x; asm volatile("" : "+v"(tid_));
    const int tid = tid_, wid = __builtin_amdgcn_readfirstlane(tid >> 6), lane = tid & 63, wr = wid >> 2, wc = wid & 3, fr = lane & 15, fq = lane >> 4;
    const int K = F8 ? (g.K >> 1) : g.K, nt = K / BK;
    unsigned voffA[2], voffB[2];
#pragma unroll
    for (int i = 0; i < 2; ++i) { int R, C; stage_rc(tid * 16 + i * 8192, R, C); const int Rb = Epi::PERM ? ((R & ~31) + perm32(R & 31)) : R;
        voffA[i] = (unsigned)(R * K + C) * 2u; voffB[i] = (unsigned)(Rb * K + C) * 2u; }
    const size_t kstep = (size_t)(BK * 2);
    const size_t hstep = (size_t)HALF * K * 2;
    const size_t tstep = 2 * hstep;
    const unsigned ldsb = (unsigned)(size_t)lds;
    const unsigned ldsw = (unsigned)wid * 1024u;
    const int aoff = lds_byte(wr * 64 + fr, fq * 8), boff = lds_byte(wc * 32 + fr, fq * 8);
#define PG8_SA(b, h) (((b) * 2 + (h)) * HTB)
#define PG8_SB(b, h) ((4 + (b) * 2 + (h)) * HTB)
#define PG8_STAGE(bufoff, gbase, voff) do { _Pragma("unroll") for (int _i = 0; _i < 2; ++_i) \
        pg8_glds((const char*)(gbase), (voff)[_i], ldsb + (unsigned)((bufoff) + _i * 8192) + ldsw); } while (0)
#define PG8_LDA(dst, b, h) do { _Pragma("unroll") for (int m = 0; m < 4; ++m) _Pragma("unroll") for (int k = 0; k < 2; ++k) dst[m][k] = *(const PG8_LAS bf16x8*)(lds + PG8_SA(b, h) + aoff + m * 2048 + k * 1024); } while (0)
#define PG8_LDB(dst, b, h) do { _Pragma("unroll") for (int n = 0; n < 2; ++n) _Pragma("unroll") for (int k = 0; k < 2; ++k) dst[n][k] = *(const PG8_LAS bf16x8*)(lds + PG8_SB(b, h) + boff + n * 2048 + k * 1024); } while (0)
#define PG8_MMA(ai, bj, At, Bt, Z) do { __builtin_amdgcn_s_setprio(1); _Pragma("unroll") for (int m = 0; m < 4; ++m) _Pragma("unroll") for (int n = 0; n < 2; ++n) { \
        if constexpr (F8) { typedef int v8i_t __attribute__((ext_vector_type(8))); typedef int v4i_t __attribute__((ext_vector_type(4))); \
            const v4i_t b0_ = __builtin_bit_cast(v4i_t, Bt[n][0]), b1_ = __builtin_bit_cast(v4i_t, Bt[n][1]), a0_ = __builtin_bit_cast(v4i_t, At[m][0]), a1_ = __builtin_bit_cast(v4i_t, At[m][1]); \
            const v8i_t bw_ = {b0_[0], b0_[1], b0_[2], b0_[3], b1_[0], b1_[1], b1_[2], b1_[3]}, aw_ = {a0_[0], a0_[1], a0_[2], a0_[3], a1_[0], a1_[1], a1_[2], a1_[3]}; \
            if constexpr (Z) asm volatile("v_mfma_f32_16x16x128_f8f6f4 %0, %1, %2, 0" : "=v"(acc[ai][bj][m][n]) : "v"(bw_), "v"(aw_)); \
            else asm volatile("v_mfma_f32_16x16x128_f8f6f4 %0, %1, %2, %0" : "+v"(acc[ai][bj][m][n]) : "v"(bw_), "v"(aw_)); } \
        else { _Pragma("unroll") for (int k = 0; k < 2; ++k) acc[ai][bj][m][n] = __builtin_amdgcn_mfma_f32_16x16x32_bf16(Bt[n][k], At[m][k], acc[ai][bj][m][n], 0, 0, 0); } } \
        __builtin_amdgcn_s_setprio(0); } while (0)
#define PG8_WAIT_V(n) asm volatile("s_waitcnt vmcnt(" #n ")" ::: "memory")
#define PG8_WAIT_L(n) asm volatile("s_waitcnt lgkmcnt(" #n ")" ::: "memory")
#define PG8_BAR __builtin_amdgcn_s_barrier()
#define PG8_SCHED __builtin_amdgcn_sched_barrier(0)
    constexpr bool FK = F8 && SP2;
    constexpr bool ZF = FK && (PG8_OPT_Z != 0);
    Unit cur, nxt; int ui = 0;
    if (!S.next(0, cur)) return;
    f32x4 acc[2][2][4][2];
#pragma unroll
    for (int a = 0; a < 2; ++a)
#pragma unroll
        for (int b = 0; b < 2; ++b)
#pragma unroll
            for (int m = 0; m < 4; ++m)
#pragma unroll
                for (int n = 0; n < 2; ++n) acc[a][b][m][n] = (f32x4){0.f, 0.f, 0.f, 0.f};
    bf16x8 At[4][2], B0[2][2], B1[2][2];
    const char* cA = (const char*)g.A + (size_t)cur.pa * tstep; const char* cB = (const char*)g.Bt + (size_t)cur.pe * g.estep + (size_t)cur.pn * tstep;
    S.a_ready(cur);
    if constexpr (SP2) {
        PG8_STAGE(PG8_SB(0, 0), cB, voffB); PG8_STAGE(PG8_SB(0, 1), cB + hstep, voffB); PG8_STAGE(PG8_SA(0, 0), cA, voffA); PG8_STAGE(PG8_SA(0, 1), cA + hstep, voffA);
        if (wr == 1) PG8_BAR;
        PG8_WAIT_V(2); PG8_BAR;
        PG8_STAGE(PG8_SB(1, 0), cB + kstep, voffB); PG8_STAGE(PG8_SA(1, 0), cA + kstep, voffA); PG8_STAGE(PG8_SB(1, 1), cB + hstep + kstep, voffB);
        PG8_WAIT_V(6); PG8_BAR;
    } else {
        PG8_STAGE(PG8_SB(0, 0), cB, voffB); PG8_STAGE(PG8_SA(0, 0), cA, voffA); PG8_STAGE(PG8_SB(0, 1), cB + hstep, voffB); PG8_STAGE(PG8_SA(0, 1), cA + hstep, voffA);
        if (wr == 1) PG8_BAR;
        PG8_WAIT_V(4); PG8_BAR;
        PG8_STAGE(PG8_SB(1, 0), cB + kstep, voffB); PG8_STAGE(PG8_SA(1, 0), cA + kstep, voffA); PG8_STAGE(PG8_SB(1, 1), cB + hstep + kstep, voffB);
        PG8_WAIT_V(6); PG8_BAR;
    }
    for (;;) {
        bool has_next = false; const char* nA = cA; const char* nB = cB;
#define PG8_NEXT do { has_next = S.next(ui + 1, nxt); nA = has_next ? (const char*)g.A + (size_t)nxt.pa * tstep : cA; nB = has_next ? (const char*)g.Bt + (size_t)nxt.pe * g.estep + (size_t)nxt.pn * tstep : cB; } while (0)
        if constexpr (PG8_OPT_NEXT == 0 || !FK) PG8_NEXT;
#pragma unroll 1
        for (int t = 0; t < nt; t += 2) {
            const bool last = (t == nt - 2);
            const char* a1 = cA + (size_t)(t + 1) * kstep;
            const char* a2 = last ? nA : cA + (size_t)(t + 2) * kstep; const char* b2 = last ? nB : cB + (size_t)(t + 2) * kstep;
            const char* a3 = a2 + kstep; const char* b3 = b2 + kstep;
            if (last && has_next) S.a_ready(nxt);
            if constexpr (SP2) {
#define PG8_KT(b, AX, BN, AN, Z, FIRST) do { \
            PG8_LDB(B0, b, 0); PG8_LDB(B1, b, 1); PG8_SCHED; PG8_LDA(At, b, 0); PG8_STAGE(PG8_SA(1 - (b), 1), (AX) + hstep, voffA); \
            if (FIRST && ui > 0) pg8_waitv<8 + Epi::NST>(); else pg8_waitv<8>(); \
            PG8_WAIT_L(0); PG8_BAR; PG8_MMA(0, 0, At, B0, Z); if constexpr (FIRST && PG8_OPT_NEXT == 1) PG8_NEXT; PG8_MMA(0, 1, At, B1, Z); PG8_BAR; PG8_SCHED; \
            PG8_LDA(At, b, 1); PG8_STAGE(PG8_SB(b, 0), BN, voffB); PG8_STAGE(PG8_SB(b, 1), (BN) + hstep, voffB); PG8_STAGE(PG8_SA(b, 0), AN, voffA); \
            if (FIRST && ui > 0) pg8_waitv<8 + Epi::NST>(); else pg8_waitv<8>(); \
            PG8_WAIT_L(0); PG8_BAR; PG8_MMA(1, 0, At, B0, Z); PG8_MMA(1, 1, At, B1, Z); PG8_BAR; PG8_SCHED; } while (0)
            if constexpr (FK) { if (t == 0) PG8_KT(0, a1, b2, a2, ZF, true); else PG8_KT(0, a1, b2, a2, false, false); }
            else PG8_KT(0, a1, b2, a2, false, false);
            PG8_KT(1, a2, b3, a3, false, false);
            } else {
            if (t == 0) PG8_NEXT;
            PG8_LDB(B0, 0, 0); PG8_SCHED; PG8_LDA(At, 0, 0); PG8_STAGE(PG8_SA(1, 1), a1 + hstep, voffA);
            PG8_WAIT_L(8); PG8_BAR; PG8_WAIT_L(0); PG8_MMA(0, 0, At, B0, false); PG8_BAR; PG8_SCHED;
            PG8_LDB(B1, 0, 1); PG8_STAGE(PG8_SB(0, 0), b2, voffB);
            PG8_BAR; PG8_WAIT_L(0); PG8_MMA(0, 1, At, B1, false); PG8_BAR;
            PG8_LDA(At, 0, 1); PG8_STAGE(PG8_SA(0, 0), a2, voffA);
            PG8_BAR; PG8_WAIT_L(0); PG8_MMA(1, 0, At, B0, false); PG8_BAR; PG8_SCHED;
            PG8_STAGE(PG8_SB(0, 1), b2 + hstep, voffB);
            PG8_WAIT_V(6); PG8_BAR; PG8_MMA(1, 1, At, B1, false); PG8_BAR;
            PG8_LDB(B0, 1, 0); PG8_SCHED; PG8_LDA(At, 1, 0); PG8_STAGE(PG8_SA(0, 1), a2 + hstep, voffA);
            PG8_WAIT_L(8); PG8_BAR; PG8_WAIT_L(0); PG8_MMA(0, 0, At, B0, false); PG8_BAR; PG8_SCHED;
            PG8_LDB(B1, 1, 1); PG8_STAGE(PG8_SB(1, 0), b3, voffB);
            PG8_BAR; PG8_WAIT_L(0); PG8_MMA(0, 1, At, B1, false); PG8_BAR;
            PG8_LDA(At, 1, 1); PG8_STAGE(PG8_SA(1, 0), a3, voffA);
            PG8_BAR; PG8_WAIT_L(0); PG8_MMA(1, 0, At, B0, false); PG8_BAR; PG8_SCHED;
            PG8_STAGE(PG8_SB(1, 1), b3 + hstep, voffB);
            PG8_WAIT_V(6); PG8_BAR; PG8_MMA(1, 1, At, B1, false); PG8_BAR;
            }
        }
        if constexpr (ALIGN_EPI) { if (wr == 0) PG8_BAR; }
        if constexpr (F8) asm volatile("s_nop 15\n\ts_nop 7" ::: "memory");
        if constexpr (!Epi::AFTER_DRAIN) { int fr_ = fr, fq_ = fq; asm volatile("" : "+v"(fr_), "+v"(fq_)); E(acc, cur, wr, wc, fr_, fq_); S.done(cur); }
        if (!has_next) break;
        if constexpr (!ZF) {
#pragma unroll
        for (int a = 0; a < 2; ++a)
#pragma unroll
            for (int b = 0; b < 2; ++b)
#pragma unroll
                for (int m = 0; m < 4; ++m)
#pragma unroll
                    for (int n = 0; n < 2; ++n) acc[a][b][m][n] = (f32x4){0.f, 0.f, 0.f, 0.f}; }
        cur = nxt; cA = nA; cB = nB; ++ui;
        if constexpr (ALIGN_EPI) { if (wr == 1) PG8_BAR; }
    }
    PG8_WAIT_V(0);
    if constexpr (!ALIGN_EPI) { if (wr == 0) PG8_BAR; }
    PG8_BAR;
    if constexpr (Epi::AFTER_DRAIN) { E.fused(acc, cur, wr, wc, fr, fq, lds, wid, lane); S.done(cur); }
#undef PG8_SA
#undef PG8_SB
#undef PG8_STAGE
#undef PG8_KT
#undef PG8_NEXT
#undef PG8_LDA
#undef PG8_LDB
#undef PG8_MMA
#undef PG8_WAIT_V
#undef PG8_WAIT_L
#undef PG8_BAR
#undef PG8_SCHED
}
}

#define GAS __attribute__((address_space(1)))
#define LAS __attribute__((address_space(3)))
typedef unsigned short bf16;
typedef unsigned v4u __attribute__((ext_vector_type(4)));
typedef float f32x4 __attribute__((ext_vector_type(4)));
typedef short bf16x8 __attribute__((ext_vector_type(8)));
typedef GAS unsigned gu32;
typedef GAS unsigned long long gu64;
#define RLX_AGENT __ATOMIC_RELAXED, __HIP_MEMORY_SCOPE_AGENT
#define LDS_WAIT() asm volatile("s_waitcnt lgkmcnt(0)" ::: "memory")
#define VM_WAIT() asm volatile("s_waitcnt vmcnt(0)" ::: "memory")
__device__ __forceinline__ unsigned long long rt() { return __builtin_amdgcn_s_memrealtime(); }
__device__ __forceinline__ unsigned f2bf(float f) { unsigned u = __builtin_bit_cast(unsigned, f); return (u + 0x7fffu + ((u >> 16) & 1u)) >> 16; }
__device__ __forceinline__ unsigned pk2(float lo, float hi) { return f2bf(lo) | (f2bf(hi) << 16); }

#define XB_TMO      128
#define XB_XCNT(j)  (256  + 64 * (j))
#define XB_XSUB(j)  (1280 + 64 * (j))
#define XB_XGEN(j)  (2304 + 64 * (j))
#define XB_TOP      3328
#define XB_TOPGEN   3392
#define XCD_BAR_WORDS 3456
#define XB_SPIN_CAP (1u << 18)

__device__ __forceinline__ unsigned xb_ld(unsigned* p)              { return __hip_atomic_load(p, __ATOMIC_RELAXED, __HIP_MEMORY_SCOPE_AGENT); }
__device__ __forceinline__ unsigned xb_add(unsigned* p, unsigned v) { return __hip_atomic_fetch_add(p, v, __ATOMIC_RELAXED, __HIP_MEMORY_SCOPE_AGENT); }
__device__ __forceinline__ unsigned xb_xcc_id() { return (unsigned)__builtin_amdgcn_s_getreg((3 << 11) | 20) & 0xFu; }
#define XB_SPIN(cond, bar) do { unsigned _sp = 0; while (cond) { __builtin_amdgcn_s_sleep(1); \
    if ((++_sp & 255u) == 0u) { if (xb_ld(&(bar)[XB_TMO])) break; if (_sp > XB_SPIN_CAP) { atomicAdd(&(bar)[XB_TMO], 1u); break; } } } } while (0)

struct XcdBarrier {
    unsigned* bar; unsigned x;
    volatile LAS unsigned* st;
};

__device__ __forceinline__ XcdBarrier xcd_barrier_post(unsigned* bar, volatile LAS unsigned* st) {
    XcdBarrier b; b.bar = bar; b.x = xb_xcc_id(); b.st = st;
    if (threadIdx.x == 0) (void)xb_add(&bar[XB_XCNT(b.x)], 1u);
    return b;
}
__device__ __forceinline__ void xcd_barrier_complete(unsigned* bar, unsigned x, unsigned& nloc, unsigned& nx) {
    const unsigned G = gridDim.x * gridDim.y * gridDim.z;
    unsigned sum, cnt, mine, sp = 0u;
    for (;;) {
        sum = 0u; cnt = 0u; mine = 0u;
#pragma unroll
        for (unsigned j = 0; j < 16; ++j) { const unsigned c = xb_ld(&bar[XB_XCNT(j)]); sum += c; cnt += (c > 0u) ? 1u : 0u; mine = (j == x) ? c : mine; }
        if (sum == G) break;
        __builtin_amdgcn_s_sleep(1);
        if ((++sp & 255u) == 0u) { if (xb_ld(&bar[XB_TMO])) break; if (sp > XB_SPIN_CAP) { atomicAdd(&bar[XB_TMO], 1u); break; } }
    }
    nloc = mine > 0u ? mine : 1u; nx = cnt > 0u ? cnt : 1u;
}

__device__ __forceinline__ void xcd_barrier(const XcdBarrier& b) {
    asm volatile("s_waitcnt vmcnt(0)" ::: "memory");
    __syncthreads();
    if (threadIdx.x == 0) {
        unsigned* bar = b.bar;
        __builtin_amdgcn_s_waitcnt(0);
        unsigned nloc = b.st[0], nx = b.st[1];
        if (nloc == 0u) { xcd_barrier_complete(bar, b.x, nloc, nx); b.st[0] = nloc; b.st[1] = nx; }
        const unsigned old = xb_add(&bar[XB_XSUB(b.x)], 1u);
        const unsigned gen = old / nloc;
        if (old + 1u == (gen + 1u) * nloc) {
            __builtin_amdgcn_fence(__ATOMIC_RELEASE, "agent");
            asm volatile("s_waitcnt vmcnt(0)" ::: "memory");
            const unsigned og = xb_add(&bar[XB_TOP], 1u);
            const unsigned tg = og / nx;
            if (og + 1u == (tg + 1u) * nx) xb_add(&bar[XB_TOPGEN], 1u);
            else XB_SPIN(xb_ld(&bar[XB_TOPGEN]) == tg, bar);
            __builtin_amdgcn_fence(__ATOMIC_ACQUIRE, "agent");
            xb_add(&bar[XB_XGEN(b.x)], 1u);
            asm volatile("s_waitcnt vmcnt(0)" ::: "memory");
        } else {
            XB_SPIN(xb_ld(&bar[XB_XGEN(b.x)]) == gen, bar);
            __builtin_amdgcn_fence(__ATOMIC_ACQUIRE, "agent");
            asm volatile("s_waitcnt vmcnt(0)" ::: "memory");
        }
    }
    __syncthreads();
}


constexpr int NWAVES = 8;
constexpr int NTOK = 32768, DM = 1024, SEQ = 2048, INW = 2304, FF = 3584, NE = 8, DEPTH = 4;
constexpr int COL_K = 512, COL_V = 640, COL_CB = 768, COL_CC = 1280, COL_HC = 1792;
constexpr int MOE_TILES_CAP = 2 * NTOK / 256 + NE;
constexpr int MOE_ROWS_CAP = MOE_TILES_CAP * 256;
constexpr float EPS = 1e-5f;
constexpr float LOG2E = 1.4426950408889634f;
constexpr float QSCALE = 0.125f * LOG2E;
constexpr float SA_X = 4.f, SW_UP = 64.f, SA_ACT = 8.f, SW_DN = 128.f, S_YS = 32.f;
#ifndef DENSE_UP_F8
#define DENSE_UP_F8 3
#endif
#ifndef DENSE_DN_F8
#define DENSE_DN_F8 3
#endif
#define UPF8(i) ((DENSE_UP_F8 >> (i)) & 1)
#define DNF8(i) ((DENSE_DN_F8 >> (i)) & 1)
#ifndef MK_PER_PHASE
#define MK_PER_PHASE 0
#endif
#ifndef ATTN_NAIVE
#define ATTN_NAIVE 0
#endif

constexpr size_t MiB = 1u << 20;
constexpr size_t WS_CTL = 0, CTL_ZERO_BYTES = 1 * MiB;
constexpr size_t WS_WIN = 1 * MiB;
constexpr size_t WS_WOUT = 19 * MiB;
constexpr size_t WS_WDUP = 27 * MiB;
constexpr size_t WS_WDDN = 55 * MiB;
constexpr size_t WS_WMUP = 69 * MiB;
constexpr size_t WS_WMDN = 181 * MiB;
constexpr size_t MOE_SET_UP = 56 * MiB, MOE_SET_DN = 28 * MiB;
constexpr int TAILCVT_KIN = 2;
constexpr int TAILCVT_K = 4;
constexpr size_t WS_ROPEC = 237 * MiB;
constexpr size_t WS_XB = 245 * MiB;
constexpr size_t WS_SSQ = 309 * MiB;
constexpr size_t WS_RT = 310 * MiB;
constexpr size_t WS_LIST = 311 * MiB;
constexpr size_t WS_ACT = 312 * MiB;
constexpr size_t WS_PROJ = WS_ACT, WS_Y = WS_ACT + 144 * MiB;
constexpr size_t WS_XS = WS_ACT + 232 * MiB;
constexpr size_t WS_XF8 = WS_ACT + 240 * MiB;
constexpr size_t WS_YS = 774 * MiB;
constexpr size_t WS_END = 906 * MiB;
static_assert(WS_ACT + (size_t)MOE_ROWS_CAP * FF * 2 <= WS_YS && WS_YS + (size_t)MOE_ROWS_CAP * DM * 2 <= WS_END, "ws map");
static_assert((size_t)NTOK * INW * 2 <= 144 * MiB, "proj fits");
static_assert((size_t)MOE_ROWS_CAP * FF <= 232 * MiB && WS_XS + (size_t)NE * NTOK * DM <= WS_END, "xs placement");
constexpr int CW_BAR = 4096;
constexpr int CW_MOECNT = 16384;

constexpr int RING_OFF = 0, RING_BYTES = 131072;
constexpr int LDSCTL_OFF = RING_BYTES, MISC_OFF = LDSCTL_OFF + 320;
constexpr int SSQT_OFF = RING_BYTES + 1024;
constexpr int LDS_BYTES = 147456;
static_assert(SSQT_OFF + 4096 <= LDS_BYTES, "LDS map");

__device__ __forceinline__ float wave_sum(float v) {
#pragma unroll
    for (int o = 1; o < 64; o <<= 1) v += __shfl_xor(v, o);
    return v;
}
__device__ __forceinline__ float wave_max(float v) {
#pragma unroll
    for (int o = 1; o < 64; o <<= 1) v = fmaxf(v, __shfl_xor(v, o));
    return v;
}
typedef unsigned v2u __attribute__((ext_vector_type(2)));
__device__ __forceinline__ float bf2f(unsigned short b) { return __builtin_bit_cast(float, (unsigned)b << 16); }
__device__ __forceinline__ float bflo(unsigned w) { return __builtin_bit_cast(float, w << 16); }
__device__ __forceinline__ float bfhi(unsigned w) { return __builtin_bit_cast(float, w & 0xffff0000u); }

__device__ __forceinline__ void tr_item(const float* W, int ldw, int k0, int n0, bf16* WT, int ldt, int r0, const float* kscale, LAS float* scr, int lane) {
#pragma unroll 8
    for (int i = 0; i < 32; ++i) { const int kk = 2 * i + (lane >> 5); float v = W[(size_t)(k0 + kk) * ldw + n0 + (lane & 31)]; if (kscale) v *= kscale[k0 + kk]; scr[kk * 33 + (lane & 31)] = v; }
    LDS_WAIT(); asm volatile("" ::: "memory");
    const int c = lane & 7;
#pragma unroll
    for (int j = 0; j < 4; ++j) { const int n = (lane >> 3) + 8 * j; const LAS float* s = scr + (8 * c) * 33 + n;
        v4u o; o.x = pk2(s[0 * 33], s[1 * 33]); o.y = pk2(s[2 * 33], s[3 * 33]); o.z = pk2(s[4 * 33], s[5 * 33]); o.w = pk2(s[6 * 33], s[7 * 33]);
        *(GAS v4u*)(WT + (size_t)(r0 + n) * ldt + k0 + 8 * c) = o; }
    LDS_WAIT(); asm volatile("" ::: "memory");
}

template <int MODE> __device__ __forceinline__ void cvt_item(const float* W, int ldw, int k0, int n0, bf16* WT, int ldt, int sel, const float* kscale, int lane) {
    const int n = n0 + 4 * lane; f32x4 v[8];
#pragma unroll
    for (int j = 0; j < 8; ++j) v[j] = *(const GAS f32x4*)(W + (size_t)(k0 + j) * ldw + n);
    if (kscale) {
#pragma unroll
        for (int j = 0; j < 8; ++j) v[j] = v[j] * kscale[k0 + j];
    }
    int r = n;
    if (MODE == 1) { const int pn = n >> 8, loc = n & 255; r = 256 * pn + 128 * ((loc >> 5) & 1) + 32 * (loc >> 6) + (loc & 31); }
    if (MODE == 2) r = 256 * (n >> 7) + 128 * sel + (n & 127);
#pragma unroll
    for (int i = 0; i < 4; ++i) { v4u o; o.x = pk2(v[0][i], v[1][i]); o.y = pk2(v[2][i], v[3][i]); o.z = pk2(v[4][i], v[5][i]); o.w = pk2(v[6][i], v[7][i]);
        *(GAS v4u*)(WT + (size_t)(r + i) * ldt + k0) = o; }
}

template <int MODE> __device__ __forceinline__ void cvt_item_f8(const float* W, int ldw, int k0, int n0, unsigned char* WT, int ldt, int sel, const float* kscale, float sc, int lane) {
    const int n = n0 + 4 * lane; f32x4 v[16];
#pragma unroll
    for (int j = 0; j < 16; ++j) v[j] = *(const GAS f32x4*)(W + (size_t)(k0 + j) * ldw + n);
#pragma unroll
    for (int j = 0; j < 16; ++j) v[j] = v[j] * (kscale ? kscale[k0 + j] * sc : sc);
    int r = n;
    if (MODE == 2) r = 256 * (n >> 7) + 128 * sel + (n & 127);
#pragma unroll
    for (int i = 0; i < 4; ++i) { v4u o; o.x = pg8::pk4_fp8(v[0][i], v[1][i], v[2][i], v[3][i]); o.y = pg8::pk4_fp8(v[4][i], v[5][i], v[6][i], v[7][i]);
        o.z = pg8::pk4_fp8(v[8][i], v[9][i], v[10][i], v[11][i]); o.w = pg8::pk4_fp8(v[12][i], v[13][i], v[14][i], v[15][i]);
        *(GAS v4u*)(WT + (size_t)(r + i) * ldt + k0) = o; }
}

struct Args { const float* in[17]; float* out; unsigned char* ws; int ph_lo, ph_hi; };
#define GIN(a, i) ((const float*)(const GAS float*)(a)->in[i])
#define GOUT(a) ((float*)(GAS float*)(a)->out)
typedef const __attribute__((address_space(4))) Args* KA;
enum { I_X = 0, I_POS, I_ANW, I_WIN, I_SINK, I_CONVW, I_HNW, I_WOUT, I_FNW, I_DG, I_DU, I_DD, I_RW, I_MG, I_MU, I_MD, I_FINW };

struct CvtT { const float* W; const float* ks; unsigned char* WT; int ldw, ldt, k0, n0, mode, sel, f8; float sc; };
__device__ __forceinline__ void cvt_ld(const CvtT& T, f32x4 (&v)[16], float& kv, int lane) {
    const float* p = T.W + (size_t)T.k0 * T.ldw + T.n0 + 4 * lane;
#pragma unroll
    for (int j = 0; j < 16; ++j) v[j] = *(const GAS f32x4*)(p + (size_t)j * T.ldw);
    kv = T.ks ? *(const GAS float*)(T.ks + T.k0 + (lane & 15)) : 1.0f;
}
__device__ __forceinline__ void cvt_st(const CvtT& T, f32x4 (&v)[16], float kv, int lane) {
    const int n = T.n0 + 4 * lane;
    const int kb = __builtin_bit_cast(int, kv * T.sc);
#pragma unroll
    for (int j = 0; j < 16; ++j) v[j] = v[j] * __builtin_bit_cast(float, __builtin_amdgcn_readlane(kb, j));
    int r = n;
    if (T.mode == 1) { const int pn = n >> 8, loc = n & 255; r = 256 * pn + 128 * ((loc >> 5) & 1) + 32 * (loc >> 6) + (loc & 31); }
    if (T.mode == 2) r = 256 * (n >> 7) + 128 * T.sel + (n & 127);
    if (T.f8) {
#pragma unroll
        for (int i = 0; i < 4; ++i) { v4u o; o.x = pg8::pk4_fp8(v[0][i], v[1][i], v[2][i], v[3][i]); o.y = pg8::pk4_fp8(v[4][i], v[5][i], v[6][i], v[7][i]);
            o.z = pg8::pk4_fp8(v[8][i], v[9][i], v[10][i], v[11][i]); o.w = pg8::pk4_fp8(v[12][i], v[13][i], v[14][i], v[15][i]);
            *(GAS v4u*)(T.WT + (size_t)(r + i) * T.ldt + T.k0) = o; }
    } else {
#pragma unroll
        for (int i = 0; i < 4; ++i) { v4u o0, o1; o0.x = pk2(v[0][i], v[1][i]); o0.y = pk2(v[2][i], v[3][i]); o0.z = pk2(v[4][i], v[5][i]); o0.w = pk2(v[6][i], v[7][i]);
            o1.x = pk2(v[8][i], v[9][i]); o1.y = pk2(v[10][i], v[11][i]); o1.z = pk2(v[12][i], v[13][i]); o1.w = pk2(v[14][i], v[15][i]);
            GAS v4u* dp = (GAS v4u*)((bf16*)T.WT + (size_t)(r + i) * T.ldt + T.k0); dp[0] = o0; dp[1] = o1; }
    }
}
template <class G> __device__ __forceinline__ void cvt_pipeline(const G& get, int cu, int NCU, int lane, int tlim = 0x7fffffff) {
    CvtT Ta, Tb; f32x4 va[16], vb[16]; float ka = 1.0f, kb = 1.0f;
    int t = cu; bool ha = t < tlim && get(t, Ta); if (ha) cvt_ld(Ta, va, ka, lane);
    while (ha) {
        t += NCU; const bool hb = t < tlim && get(t, Tb); if (hb) cvt_ld(Tb, vb, kb, lane);
        cvt_st(Ta, va, ka, lane);
        if (!hb) break;
        t += NCU; ha = t < tlim && get(t, Ta); if (ha) cvt_ld(Ta, va, ka, lane);
        cvt_st(Tb, vb, kb, lane);
    }
}
struct MoeCvt { KA a; unsigned char* ws; int i, l, wave;
    __device__ __forceinline__ bool operator()(int t, CvtT& T) const {
        constexpr int T_G = 8 * 14, T_D = 28 * 4, PER_E = 2 * T_G + T_D;
        if (t >= NE * PER_E) return false;
        const int e = t / PER_E; int r = t % PER_E;
        if (r < 2 * T_G) { const int sel = r / T_G, q = r % T_G;
            T = CvtT{GIN(a, sel ? I_MU : I_MG) + (size_t)(i * NE + e) * DM * FF, GIN(a, I_FNW) + l * DM, ws + WS_WMUP + (size_t)i * MOE_SET_UP + (size_t)e * 2 * FF * DM, FF, DM, 16 * ((q / 14) * 8 + wave), 256 * (q % 14), 2, sel, 1, SW_UP}; }
        else { r -= 2 * T_G;
            T = CvtT{GIN(a, I_MD) + (size_t)(i * NE + e) * FF * DM, nullptr, ws + WS_WMDN + (size_t)i * MOE_SET_DN + (size_t)e * DM * FF, DM, FF, 16 * ((r / 4) * 8 + wave), 256 * (r % 4), 0, 0, 1, SW_DN}; }
        return true; } };
struct ProCvt { KA a; unsigned char* ws; int wave;
    __device__ __forceinline__ bool operator()(int t, CvtT& T) const {
        constexpr int T_IN = 8 * 9, T_OUT = 8 * 4, T_G = 8 * 14, T_D = 28 * 4;
        if (t >= 4 * T_IN + 4 * T_OUT + 4 * T_G + 2 * T_D) return false;
        int r = t;
        if (r < 4 * T_IN) { const int l = r / T_IN, q = r % T_IN;
            T = CvtT{GIN(a, I_WIN) + (size_t)l * DM * INW, GIN(a, I_ANW) + l * DM, ws + WS_WIN + (size_t)l * INW * DM * 2, INW, DM, 16 * ((q / 9) * 8 + wave), 256 * (q % 9), 1, 0, 0, 1.0f}; return true; }
        r -= 4 * T_IN;
        if (r < 4 * T_OUT) { const int l = r / T_OUT, q = r % T_OUT;
            T = CvtT{GIN(a, I_WOUT) + (size_t)l * DM * DM, nullptr, ws + WS_WOUT + (size_t)l * DM * DM * 2, DM, DM, 16 * ((q / 4) * 8 + wave), 256 * (q % 4), 0, 0, 0, 1.0f}; return true; }
        r -= 4 * T_OUT;
        if (r < 4 * T_G) { const int sel = r / (2 * T_G), rr = r % (2 * T_G), i = rr / T_G, q = rr % T_G; const int f8 = UPF8(i);
            T = CvtT{GIN(a, sel ? I_DU : I_DG) + (size_t)i * DM * FF, GIN(a, I_FNW) + (2 * i) * DM, ws + WS_WDUP + (size_t)i * 2 * FF * DM * 2, FF, DM, 16 * ((q / 14) * 8 + wave), 256 * (q % 14), 2, sel, f8, f8 ? SW_UP : 1.0f}; return true; }
        r -= 4 * T_G;
        { const int i = r / T_D, q = r % T_D; const int f8 = DNF8(i);
            T = CvtT{GIN(a, I_DD) + (size_t)i * FF * DM, nullptr, ws + WS_WDDN + (size_t)i * DM * FF * 2, DM, FF, 16 * ((q / 4) * 8 + wave), 256 * (q % 4), 0, 0, f8, f8 ? SW_DN : 1.0f}; return true; } } };

__device__ const double INVF_REV[32] = {
    0.15915494309189535, 0.11934937021124886, 0.08949940160889101, 0.06711508300522726,
    0.050329212104487035, 0.03774158471741977, 0.0283021958306234, 0.02122365276477766,
    0.015915494309189534, 0.011934937021124886, 0.008949940160889102, 0.006711508300522725,
    0.005032921210448704, 0.003774158471741977, 0.00283021958306234, 0.0021223652764777662,
    0.0015915494309189536, 0.0011934937021124885, 0.0008949940160889102, 0.0006711508300522726,
    0.0005032921210448703, 0.00037741584717419774, 0.00028302195830623395, 0.0002122365276477766,
    0.00015915494309189535, 0.00011934937021124886, 8.949940160889102e-05, 6.711508300522725e-05,
    5.0329212104487035e-05, 3.774158471741978e-05, 2.8302195830623396e-05, 2.122365276477766e-05
};

__device__ __forceinline__ void p_prologue(KA a, unsigned char* ws, LAS unsigned char* lds, int gw, int NGW, int wave, int lane, int gtid, int NGT) {
    { const ProCvt get{a, ws, wave}; cvt_pipeline(get, gw >> 3, NGW >> 3, lane); }
    { const int* pos = (const int*)GIN(a, I_POS); unsigned* rcs = (unsigned*)(ws + WS_ROPEC);
      for (int i = gtid; i < NTOK * 32; i += NGT) { const int t = i >> 5, j = i & 31; double r = (double)pos[t] * INVF_REV[j]; r -= floor(r);
          const float rf = (float)r; const _Float16 ch = (_Float16)__builtin_amdgcn_cosf(rf), sh = (_Float16)__builtin_amdgcn_sinf(rf);
          rcs[i] = (unsigned)__builtin_bit_cast(unsigned short, ch) | ((unsigned)__builtin_bit_cast(unsigned short, sh) << 16); } }
    { const float* x = GIN(a, I_X); bf16* xb = (bf16*)(ws + WS_XB); float* ssq = (float*)(ws + WS_SSQ);
      for (int m0 = gw; m0 < NTOK; m0 += 4 * NGW) {
          f32x4 v[4][4];
#pragma unroll
          for (int b = 0; b < 4; ++b) { const int m = (m0 + b * NGW < NTOK) ? m0 + b * NGW : m0; const GAS f32x4* xr = (const GAS f32x4*)(x + (size_t)m * DM) + lane;
#pragma unroll
              for (int j = 0; j < 4; ++j) v[b][j] = xr[64 * j]; }
#pragma unroll
          for (int b = 0; b < 4; ++b) { const int m = m0 + b * NGW; if (m < NTOK) { float s = 0.f;
#pragma unroll
              for (int j = 0; j < 4; ++j) s += (v[b][j].x * v[b][j].x + v[b][j].y * v[b][j].y) + (v[b][j].z * v[b][j].z + v[b][j].w * v[b][j].w);
              s = wave_sum(s);
              GAS unsigned long long* o8 = (GAS unsigned long long*)(xb + (size_t)m * DM) + lane;
#pragma unroll
              for (int j = 0; j < 4; ++j) o8[64 * j] = (unsigned long long)pk2(v[b][j].x, v[b][j].y) | ((unsigned long long)pk2(v[b][j].z, v[b][j].w) << 32);
              if (lane == 0) *(GAS f32x4*)(ssq + (size_t)m * 4) = (f32x4){s, 0.f, 0.f, 0.f}; } } } }
}

__device__ __forceinline__ void p_moe_weights(KA a, unsigned char* ws, LAS unsigned char* lds, int i, int gw, int NGW, int wave, int lane, int t0 = 0) {
    const MoeCvt get{a, ws, i, 2 * i + 1, wave}; cvt_pipeline(get, t0 + (gw >> 3), NGW >> 3, lane);
}

__device__ __forceinline__ void attn_naive_item(int t, int g, const bf16* P, const float* sinks, const float* hnw, bf16* Y, LAS float* sc, int lane) {
    const int s = t & (SEQ - 1); const int nk = (s + 1 < 128) ? (s + 1) : 128;
    { const uint2 raw = *(const uint2*)(P + (size_t)t * INW + g * 256 + lane * 4);
      sc[lane * 4 + 0] = bflo(raw.x); sc[lane * 4 + 1] = bfhi(raw.x); sc[lane * 4 + 2] = bflo(raw.y); sc[lane * 4 + 3] = bfhi(raw.y); }
    LDS_WAIT(); asm volatile("" ::: "memory");
    float d[2][4];
#pragma unroll
    for (int kk = 0; kk < 2; ++kk) {
        const int kidx = lane + 64 * kk;
#pragma unroll
        for (int h = 0; h < 4; ++h) d[kk][h] = 0.f;
        if (kidx < nk) {
            const bf16* kp = P + (size_t)(t - kidx) * INW + COL_K + g * 64;
#pragma unroll
            for (int c = 0; c < 8; ++c) { const uint4 raw = *(const uint4*)(kp + 8 * c);
                const float kf[8] = {bflo(raw.x), bfhi(raw.x), bflo(raw.y), bfhi(raw.y), bflo(raw.z), bfhi(raw.z), bflo(raw.w), bfhi(raw.w)};
#pragma unroll
                for (int h = 0; h < 4; ++h)
#pragma unroll
                    for (int e = 0; e < 8; ++e) d[kk][h] += kf[e] * sc[h * 64 + 8 * c + e]; }
        } else {
#pragma unroll
            for (int h = 0; h < 4; ++h) d[kk][h] = -INFINITY;
        }
    }
    float inv_l[4];
#pragma unroll
    for (int h = 0; h < 4; ++h) {
        const float sk = sinks[4 * g + h] * LOG2E;
        const float m = fmaxf(wave_max(fmaxf(d[0][h], d[1][h])), sk);
        const float p0 = __builtin_amdgcn_exp2f(d[0][h] - m), p1 = __builtin_amdgcn_exp2f(d[1][h] - m);
        const float l = wave_sum(p0 + p1) + __builtin_amdgcn_exp2f(sk - m);
        sc[256 + h * 128 + lane] = p0; sc[256 + h * 128 + 64 + lane] = p1; inv_l[h] = 1.0f / l;
    }
    LDS_WAIT(); asm volatile("" ::: "memory");
    float o[4] = {0.f, 0.f, 0.f, 0.f};
    const bf16* vp = P + (size_t)t * INW + COL_V + g * 64 + lane;
    for (int key = 0; key < nk; ++key) { const float v = bf2f(vp[-(ptrdiff_t)key * INW]);
#pragma unroll
        for (int h = 0; h < 4; ++h) o[h] += sc[256 + h * 128 + key] * v; }
#pragma unroll
    for (int h = 0; h < 4; ++h) { const float ov = o[h] * inv_l[h]; const float ss = wave_sum(ov * ov); const float r = __builtin_amdgcn_rsqf(ss * (1.0f / 64.0f) + EPS);
        const int col = (4 * g + h) * 64 + lane; Y[(size_t)t * DM + col] = (bf16)f2bf(ov * r * hnw[col]); }
    LDS_WAIT(); asm volatile("" ::: "memory");
}
typedef float f32x16 __attribute__((ext_vector_type(16)));
typedef short s16x4 __attribute__((ext_vector_type(4)));
__device__ __forceinline__ s16x4 vtr(const LAS unsigned char* p) { return __builtin_bit_cast(s16x4, __builtin_amdgcn_ds_read_tr16_b64_v4i16((LAS s16x4*)p)); }
__device__ __forceinline__ unsigned cvtpk(float lo, float hi) { unsigned r; asm volatile("v_cvt_pk_bf16_f32 %0, %1, %2" : "=v"(r) : "v"(lo), "v"(hi)); return r; }
__device__ __forceinline__ void attn_unit(int b, int g, int qb, const bf16* P, const float* sinks, const float* hnw, bf16* Y, LAS unsigned char* lds, int wave, int lane) {
    const int tokb = b * SEQ + qb * 128;
#pragma unroll
    for (int i = 0; i < 8; ++i) {
        const int piece = wave * 8 + i, isV = piece >> 5, pp = piece & 31, slot = pp * 64 + lane, kk = slot >> 3, cs = slot & 7;
        const int c = isV ? (cs ^ (4 * ((kk >> 1) & 1))) : (cs ^ ((kk >> 1) & 7));
        int tok = tokb - 128 + kk; if (qb == 0 && kk < 128) tok += 128;
        const bf16* src = P + (size_t)tok * INW + (isV ? COL_V : COL_K) + g * 64 + 8 * c;
        __builtin_amdgcn_global_load_lds((const unsigned*)src, (LAS unsigned*)(lds + isV * 32768 + pp * 1024), 16, 0, 0);
    }
    const int h = 4 * g + (wave >> 1), hw = wave & 1, r = lane & 31, hh = lane >> 5;
    const float sk = sinks[h] * LOG2E;
    const int kswz = (r >> 1) & 7;
    const int q4 = (lane & 15) >> 2, sw = (q4 >> 1) & 1, xoff = 32 * ((lane >> 4) & 1) + 8 * (lane & 3);
    const int voff0 = 64 * sw + xoff, voff1 = 64 * (1 - sw) + xoff;
    asm volatile("s_waitcnt vmcnt(0)" ::: "memory"); __builtin_amdgcn_s_barrier(); asm volatile("" ::: "memory");
#pragma unroll 1
    for (int sb = 0; sb < 2; ++sb) {
        const int T0 = 2 * hw + sb;
        const int tok = tokb + 32 * T0 + r;
        const bf16* qrow = P + (size_t)tok * INW + h * 64 + 8 * hh;
        bf16x8 qf[4];
#pragma unroll
        for (int ds = 0; ds < 4; ++ds) qf[ds] = *(const bf16x8*)(qrow + 16 * ds);
        f32x16 st[5];
        const LAS unsigned char* kr = lds + (32 * T0 + r) * 128;
#pragma unroll
        for (int ti = 0; ti < 5; ++ti) {
            f32x16 acc = {0.f, 0.f, 0.f, 0.f, 0.f, 0.f, 0.f, 0.f, 0.f, 0.f, 0.f, 0.f, 0.f, 0.f, 0.f, 0.f};
#pragma unroll
            for (int ds = 0; ds < 4; ++ds) { const bf16x8 a = *(const LAS bf16x8*)(kr + ti * 4096 + (((2 * ds + hh) ^ kswz) << 4)); acc = __builtin_amdgcn_mfma_f32_32x32x16_bf16(a, qf[ds], acc, 0, 0, 0); }
            st[ti] = acc;
        }
        float m = -INFINITY;
#pragma unroll
        for (int ti = 0; ti < 5; ++ti)
#pragma unroll
            for (int rg = 0; rg < 16; ++rg) { const int cr = (rg & 3) + 8 * (rg >> 2) + 4 * hh; bool vis = true;
                if (ti == 0) vis = cr > r; if (ti == 4) vis = cr <= r; if (qb == 0 && T0 + ti < 4) vis = false;
                const float sv = vis ? st[ti][rg] : -INFINITY; st[ti][rg] = sv; m = fmaxf(m, sv); }
        m = fmaxf(m, __shfl_xor(m, 32)); m = fmaxf(m, sk);
        float l = 0.f;
#pragma unroll
        for (int ti = 0; ti < 5; ++ti)
#pragma unroll
            for (int rg = 0; rg < 16; ++rg) { const float pv = __builtin_amdgcn_exp2f(st[ti][rg] - m); st[ti][rg] = pv; l += pv; }
        l += __shfl_xor(l, 32); l += __builtin_amdgcn_exp2f(sk - m);
        f32x16 o0 = {0.f, 0.f, 0.f, 0.f, 0.f, 0.f, 0.f, 0.f, 0.f, 0.f, 0.f, 0.f, 0.f, 0.f, 0.f, 0.f}, o1 = o0;
        const LAS unsigned char* vb = lds + 32768 + T0 * 4096 + (4 * hh + q4) * 128;
#pragma unroll
        for (int ti = 0; ti < 5; ++ti)
#pragma unroll
            for (int ks = 0; ks < 2; ++ks) {
                v4u pw; pw.x = cvtpk(st[ti][8 * ks + 0], st[ti][8 * ks + 1]); pw.y = cvtpk(st[ti][8 * ks + 2], st[ti][8 * ks + 3]); pw.z = cvtpk(st[ti][8 * ks + 4], st[ti][8 * ks + 5]); pw.w = cvtpk(st[ti][8 * ks + 6], st[ti][8 * ks + 7]);
                const bf16x8 pf = __builtin_bit_cast(bf16x8, pw);
                const LAS unsigned char* vp = vb + ti * 4096 + ks * 2048;
                { const s16x4 lo = vtr(vp + voff0), hi = vtr(vp + 1024 + voff0); const bf16x8 vf = {lo[0], lo[1], lo[2], lo[3], hi[0], hi[1], hi[2], hi[3]}; o0 = __builtin_amdgcn_mfma_f32_32x32x16_bf16(vf, pf, o0, 0, 0, 0); }
                { const s16x4 lo = vtr(vp + voff1), hi = vtr(vp + 1024 + voff1); const bf16x8 vf = {lo[0], lo[1], lo[2], lo[3], hi[0], hi[1], hi[2], hi[3]}; o1 = __builtin_amdgcn_mfma_f32_32x32x16_bf16(vf, pf, o1, 0, 0, 0); }
            }
        const float il = 1.0f / l; float ss = 0.f;
#pragma unroll
        for (int rg = 0; rg < 16; ++rg) { o0[rg] *= il; o1[rg] *= il; ss += o0[rg] * o0[rg] + o1[rg] * o1[rg]; }
        ss += __shfl_xor(ss, 32);
        const float rn = __builtin_amdgcn_rsqf(ss * (1.0f / 64.0f) + EPS);
        bf16* yrow = Y + (size_t)tok * DM + h * 64 + 4 * hh; const float* wrow = hnw + h * 64 + 4 * hh;
#pragma unroll
        for (int q = 0; q < 4; ++q) {
            const f32x4 w0 = *(const f32x4*)(wrow + 8 * q), w1 = *(const f32x4*)(wrow + 32 + 8 * q);
            v2u a; a.x = cvtpk(o0[4 * q + 0] * rn * w0[0], o0[4 * q + 1] * rn * w0[1]); a.y = cvtpk(o0[4 * q + 2] * rn * w0[2], o0[4 * q + 3] * rn * w0[3]);
            v2u c; c.x = cvtpk(o1[4 * q + 0] * rn * w1[0], o1[4 * q + 1] * rn * w1[1]); c.y = cvtpk(o1[4 * q + 2] * rn * w1[2], o1[4 * q + 3] * rn * w1[3]);
            *(GAS v2u*)(yrow + 8 * q) = a; *(GAS v2u*)(yrow + 32 + 8 * q) = c;
        }
    }
    asm volatile("s_waitcnt lgkmcnt(0)" ::: "memory"); __builtin_amdgcn_s_barrier(); asm volatile("" ::: "memory");
}
__device__ __forceinline__ void load_u8(const bf16* P, int t, int ch, float* u) {
    const uint4 c = *(const uint4*)(P + (size_t)t * INW + COL_CC + ch); const uint4 h = *(const uint4*)(P + (size_t)t * INW + COL_HC + ch);
    u[0] = bflo(c.x) * bflo(h.x); u[1] = bfhi(c.x) * bfhi(h.x); u[2] = bflo(c.y) * bflo(h.y); u[3] = bfhi(c.y) * bfhi(h.y);
    u[4] = bflo(c.z) * bflo(h.z); u[5] = bfhi(c.z) * bfhi(h.z); u[6] = bflo(c.w) * bflo(h.w); u[7] = bfhi(c.w) * bfhi(h.w);
}
__device__ __forceinline__ void conv_item(int t0, const bf16* P, const float* cw  , const float* hnw  , bf16* Y, int lane) {
    const int ch = 8 * lane; float w0[8], w1[8], w2[8], hw[8], u1[8], u2[8];
#pragma unroll
    for (int i = 0; i < 8; ++i) { w0[i] = cw[ch + i]; w1[i] = cw[512 + ch + i]; w2[i] = cw[1024 + ch + i]; hw[i] = hnw[512 + ch + i]; u1[i] = 0.f; u2[i] = 0.f; }
    if ((t0 & (SEQ - 1)) != 0) { load_u8(P, t0 - 1, ch, u1); load_u8(P, t0 - 2, ch, u2); }
    for (int tb = t0; tb < t0 + 16; tb += 4) {
        uint4 cc[4], hh[4], bb[4];
#pragma unroll
        for (int q = 0; q < 4; ++q) { const bf16* row = P + (size_t)(tb + q) * INW + ch; cc[q] = *(const uint4*)(row + COL_CC); hh[q] = *(const uint4*)(row + COL_HC); bb[q] = *(const uint4*)(row + COL_CB); }
#pragma unroll
        for (int q = 0; q < 4; ++q) { const int t = tb + q; const uint4 c = cc[q], h = hh[q], b = bb[q];
            const float u[8] = {bflo(c.x) * bflo(h.x), bfhi(c.x) * bfhi(h.x), bflo(c.y) * bflo(h.y), bfhi(c.y) * bfhi(h.y), bflo(c.z) * bflo(h.z), bfhi(c.z) * bfhi(h.z), bflo(c.w) * bflo(h.w), bfhi(c.w) * bfhi(h.w)};
            const float gb[8] = {bflo(b.x), bfhi(b.x), bflo(b.y), bfhi(b.y), bflo(b.z), bfhi(b.z), bflo(b.w), bfhi(b.w)};
            float o[8]; float ss = 0.f;
#pragma unroll
            for (int i = 0; i < 8; ++i) { o[i] = gb[i] * (w0[i] * u2[i] + w1[i] * u1[i] + w2[i] * u[i]); ss += o[i] * o[i]; }
            ss += __shfl_xor(ss, 1); ss += __shfl_xor(ss, 2); ss += __shfl_xor(ss, 4);
            const float r = __builtin_amdgcn_rsqf(ss * (1.0f / 64.0f) + EPS);
            v4u w; w.x = pk2(o[0] * r * hw[0], o[1] * r * hw[1]); w.y = pk2(o[2] * r * hw[2], o[3] * r * hw[3]); w.z = pk2(o[4] * r * hw[4], o[5] * r * hw[5]); w.w = pk2(o[6] * r * hw[6], o[7] * r * hw[7]);
            *(GAS v4u*)(Y + (size_t)t * DM + 512 + ch) = w;
#pragma unroll
            for (int i = 0; i < 8; ++i) { u2[i] = u1[i]; u1[i] = u[i]; } }
    }
}

struct MoeMeta { int cnt[8]; int rowstart[8]; int tend[8]; int ntiles; };
__device__ __forceinline__ MoeMeta moe_meta(gu32* ctl, int i) {
    MoeMeta m; int acc = 0;
#pragma unroll
    for (int e = 0; e < 8; ++e) { m.cnt[e] = __builtin_amdgcn_readfirstlane((int)__hip_atomic_load(ctl + CW_MOECNT + (i * 8 + e) * 64, RLX_AGENT)); m.rowstart[e] = acc * 256; acc += (m.cnt[e] + 255) >> 8; m.tend[e] = acc; }
    m.ntiles = acc; return m;
}
__device__ __forceinline__ int tailcvt_idle_in(int G) { const int r = ((NTOK / 256) * (INW / 256)) % G; return r != 0 ? G - r : 0; }
__device__ __forceinline__ int tailcvt_idle(gu32* ctl, int G) { const MoeMeta m0 = moe_meta(ctl, 0); const int nu = m0.ntiles * 4, r = nu % G; return (DEPTH >= 4 && r != 0) ? G - r : 0; }
__device__ __forceinline__ void p_router(KA a, unsigned char* ws, LAS unsigned char* lds, gu32* ctl, const bf16* XBm, int l, int i, int ci, int wave, int lane, int tid, int G) {
    LAS int* lcnt = (LAS int*)(lds + SSQT_OFF);
    LAS int* ltok = (LAS int*)(lds + SSQT_OFF + 256);
    LAS unsigned* lrow = (LAS unsigned*)(lds + RING_OFF);
    const int TPB = (NTOK + G - 1) / G, tb = blockIdx.x * TPB, te = (tb + TPB < NTOK) ? tb + TPB : NTOK;
    if (tid < 16) lcnt[tid] = 0;
    __syncthreads();
    int* tok_e = (int*)(ws + WS_RT); float* tok_g = (float*)(ws + WS_RT + 512 * 1024);
    float w[2][8][8];
    { const float* rw = GIN(a, I_RW) + (size_t)i * DM * NE; const float* nw = GIN(a, I_FNW) + l * DM;
#pragma unroll
      for (int j = 0; j < 2; ++j)
#pragma unroll
          for (int c = 0; c < 8; ++c) { const int d = 8 * lane + 512 * j + c; const float n = nw[d]; const f32x4 r0 = *(const f32x4*)(rw + d * 8), r1 = *(const f32x4*)(rw + d * 8 + 4);
              w[j][c][0] = r0.x * n; w[j][c][1] = r0.y * n; w[j][c][2] = r0.z * n; w[j][c][3] = r0.w * n; w[j][c][4] = r1.x * n; w[j][c][5] = r1.y * n; w[j][c][6] = r1.z * n; w[j][c][7] = r1.w * n; } }
    for (int t0 = tb + wave; t0 < te; t0 += 2 * NWAVES) {
        v4u xr2[2][2];
#pragma unroll
        for (int b = 0; b < 2; ++b) { const int t = (t0 + b * NWAVES < te) ? t0 + b * NWAVES : t0; const GAS v4u* xr = (const GAS v4u*)(XBm + (size_t)t * DM) + lane;
#pragma unroll
            for (int j = 0; j < 2; ++j) xr2[b][j] = xr[64 * j]; }
#pragma unroll
        for (int b = 0; b < 2; ++b) { const int t = t0 + b * NWAVES; if (t < te) {
        float s = 0.f; float lg[8] = {0.f, 0.f, 0.f, 0.f, 0.f, 0.f, 0.f, 0.f}; float xv[2][8];
#pragma unroll
        for (int j = 0; j < 2; ++j) { const v4u r = xr2[b][j];
            xv[j][0] = bflo(r.x); xv[j][1] = bfhi(r.x); xv[j][2] = bflo(r.y); xv[j][3] = bfhi(r.y); xv[j][4] = bflo(r.z); xv[j][5] = bfhi(r.z); xv[j][6] = bflo(r.w); xv[j][7] = bfhi(r.w); }
#pragma unroll
        for (int j = 0; j < 2; ++j)
#pragma unroll
            for (int c = 0; c < 8; ++c) { const float v = xv[j][c]; s += v * v;
#pragma unroll
                for (int e = 0; e < 8; ++e) lg[e] += v * w[j][c][e]; }
        s = wave_sum(s); const float rstd = 1.0f / sqrtf(s * (1.0f / DM) + EPS);
#pragma unroll
        for (int e = 0; e < 8; ++e) lg[e] = wave_sum(lg[e]) * rstd;
        { LAS v2u* o8 = (LAS v2u*)(lrow + (t - tb) * 256) + lane; const float rq = rstd * SA_X;
#pragma unroll
          for (int j = 0; j < 2; ++j) { v2u o; o.x = pg8::pk4_fp8(xv[j][0] * rq, xv[j][1] * rq, xv[j][2] * rq, xv[j][3] * rq); o.y = pg8::pk4_fp8(xv[j][4] * rq, xv[j][5] * rq, xv[j][6] * rq, xv[j][7] * rq); o8[64 * j] = o; } }
        int e0 = 0; float l0 = lg[0];
#pragma unroll
        for (int e = 1; e < 8; ++e) if (lg[e] > l0) { l0 = lg[e]; e0 = e; }
        int e1 = -1; float l1 = -INFINITY;
#pragma unroll
        for (int e = 0; e < 8; ++e) if (e != e0 && lg[e] > l1) { l1 = lg[e]; e1 = e; }
        const float ex = __expf(l1 - l0), g0 = 1.0f / (1.0f + ex), g1 = ex * g0;
        if (lane == 0) {
            const int r0 = __hip_atomic_fetch_add(lcnt + e0, 1, __ATOMIC_RELAXED, __HIP_MEMORY_SCOPE_WORKGROUP), r1 = __hip_atomic_fetch_add(lcnt + e1, 1, __ATOMIC_RELAXED, __HIP_MEMORY_SCOPE_WORKGROUP);
            const int tl = t - tb; ltok[tl * 4 + 0] = e0; ltok[tl * 4 + 1] = e1; ltok[tl * 4 + 2] = r0; ltok[tl * 4 + 3] = r1;
            tok_e[t * 2 + 0] = e0; tok_e[t * 2 + 1] = e1; tok_g[t * 2 + 0] = g0; tok_g[t * 2 + 1] = g1;
        }
        } }
    }
    __syncthreads();
    if (tid < 8) lcnt[8 + tid] = (int)__hip_atomic_fetch_add(ctl + CW_MOECNT + (ci * 8 + tid) * 64, (unsigned)lcnt[tid], RLX_AGENT);
    __syncthreads();
    int* tok_pos = (int*)(ws + WS_RT + 256 * 1024);
    for (int tl = tid; tl < te - tb; tl += NWAVES * 64) {
#pragma unroll
        for (int k = 0; k < 2; ++k) { const int e = ltok[tl * 4 + k], pos = lcnt[8 + e] + ltok[tl * 4 + 2 + k]; tok_pos[(tb + tl) * 2 + k] = pos; }
    }
    unsigned char* xs = ws + WS_XS;
    for (int a0 = wave; a0 < 2 * (te - tb); a0 += 8 * NWAVES) {
        v4u d[8]; size_t dst[8];
#pragma unroll
        for (int q = 0; q < 8; ++q) { const int as = a0 + q * NWAVES; const int asc = (as < 2 * (te - tb)) ? as : a0; const int tl = asc >> 1, k = asc & 1;
            const int e = ltok[tl * 4 + k], pos = lcnt[8 + e] + ltok[tl * 4 + 2 + k];
            d[q] = *((const LAS v4u*)(lrow + tl * 256) + lane); dst[q] = ((size_t)e * NTOK + pos) * DM; }
#pragma unroll
        for (int q = 0; q < 8; ++q) { const int as = a0 + q * NWAVES; if (as < 2 * (te - tb)) *((GAS v4u*)(xs + dst[q]) + lane) = d[q]; }
    }
    __syncthreads();
}
__device__ __forceinline__ void fp8x4_to_f32(unsigned w, float* o) {
    typedef float f2 __attribute__((ext_vector_type(2)));
    const f2 a = __builtin_amdgcn_cvt_pk_f32_fp8((int)w, false), b = __builtin_amdgcn_cvt_pk_f32_fp8((int)w, true);
    o[0] = a.x; o[1] = a.y; o[2] = b.x; o[3] = b.y;
}
__device__ __forceinline__ void p_combine(KA a, unsigned char* ws, gu32* ctl, bf16* XBm, float* OUT, float* ssq, int i, bool last, int gw, int NGW, int lane) {
    const MoeMeta mm = moe_meta(ctl, i);
    const int* tok_e = (const int*)(ws + WS_RT); const int* tok_pos = (const int*)(ws + WS_RT + 256 * 1024); const float* tok_g = (const float*)(ws + WS_RT + 512 * 1024);
    const unsigned char* ys = ws + WS_YS; const float* fw = GIN(a, I_FINW);
    constexpr int NB = 2;
    for (int t0 = gw; t0 < NTOK; t0 += NB * NGW) {
        int row[NB][2]; float g[NB][2];
#pragma unroll
        for (int b = 0; b < NB; ++b) { const int t = (t0 + b * NGW < NTOK) ? t0 + b * NGW : t0;
#pragma unroll
            for (int k = 0; k < 2; ++k) { const int e = tok_e[t * 2 + k]; int rs0 = 0;
#pragma unroll
                for (int j = 0; j < 8; ++j) if (j == e) rs0 = mm.rowstart[j];
                row[b][k] = rs0 + tok_pos[t * 2 + k]; g[b][k] = tok_g[t * 2 + k] * (1.0f / S_YS); } }
        v4u x[NB][2], p[NB], q[NB];
#pragma unroll
        for (int b = 0; b < NB; ++b) { const int t = (t0 + b * NGW < NTOK) ? t0 + b * NGW : t0;
            const GAS v4u* xr = (const GAS v4u*)(XBm + (size_t)t * DM) + 2 * lane;
            x[b][0] = xr[0]; x[b][1] = xr[1];
            p[b] = *((const GAS v4u*)(ys + (size_t)row[b][0] * DM) + lane); q[b] = *((const GAS v4u*)(ys + (size_t)row[b][1] * DM) + lane); }
#pragma unroll
        for (int b = 0; b < NB; ++b) { const int t = t0 + b * NGW; if (t < NTOK) {
            float v[16]; float s = 0.f;
#pragma unroll
            for (int c = 0; c < 4; ++c) { float pf[4], qf[4]; fp8x4_to_f32(p[b][c], pf); fp8x4_to_f32(q[b][c], qf);
                const unsigned x0 = x[b][c >> 1][2 * (c & 1)], x1 = x[b][c >> 1][2 * (c & 1) + 1];
                v[4 * c + 0] = bflo(x0) + (g[b][0] * pf[0] + g[b][1] * qf[0]); v[4 * c + 1] = bfhi(x0) + (g[b][0] * pf[1] + g[b][1] * qf[1]);
                v[4 * c + 2] = bflo(x1) + (g[b][0] * pf[2] + g[b][1] * qf[2]); v[4 * c + 3] = bfhi(x1) + (g[b][0] * pf[3] + g[b][1] * qf[3]); }
#pragma unroll
            for (int c = 0; c < 16; ++c) s += v[c] * v[c];
            s = wave_sum(s);
            if (last) {
                const float r = 1.0f / sqrtf(s * (1.0f / DM) + EPS);
                const GAS f32x4* wp = (const GAS f32x4*)(fw + 16 * lane); GAS f32x4* op = (GAS f32x4*)(OUT + (size_t)t * DM + 16 * lane);
#pragma unroll
                for (int c = 0; c < 4; ++c) { const f32x4 w4 = wp[c]; op[c] = (f32x4){v[4 * c] * r * w4.x, v[4 * c + 1] * r * w4.y, v[4 * c + 2] * r * w4.z, v[4 * c + 3] * r * w4.w}; }
            } else {
                GAS v4u* xo = (GAS v4u*)(XBm + (size_t)t * DM) + 2 * lane;
                v4u o0, o1; o0.x = pk2(v[0], v[1]); o0.y = pk2(v[2], v[3]); o0.z = pk2(v[4], v[5]); o0.w = pk2(v[6], v[7]); o1.x = pk2(v[8], v[9]); o1.y = pk2(v[10], v[11]); o1.z = pk2(v[12], v[13]); o1.w = pk2(v[14], v[15]);
                xo[0] = o0; xo[1] = o1;
                if (lane == 0) *(GAS f32x4*)(ssq + (size_t)t * 4) = (f32x4){s, 0.f, 0.f, 0.f};
            } } }
    }
}

#define PHASE_ENV() KA ap = ap0; GAS unsigned char* wsg_ = (GAS unsigned char*)ws0; int l = l0, G = G0, bx = bx0; asm volatile("" : "+s"(ap), "+s"(wsg_), "+s"(l), "+s"(G), "+s"(bx)); unsigned char* ws = (unsigned char*)wsg_; int tid = tid0, wave = wave0, gw = gw0, NGW = NGW0; asm volatile("" : "+v"(tid), "+s"(wave), "+s"(gw), "+s"(NGW)); int lane = tid & 63; (void)tid; (void)lane; (void)wave; (void)gw; (void)NGW; gu32* ctl = (gu32*)(ws + WS_CTL); (void)ctl; (void)l; (void)G; (void)bx
__global__ void __launch_bounds__(NWAVES * 64, 2) fwd_kernel(Args args) {
    extern __shared__ __attribute__((aligned(16))) unsigned char lds_raw[];
    LAS unsigned char* lds = (LAS unsigned char*)lds_raw;
    asm volatile("s_setreg_imm32_b32 hwreg(HW_REG_MODE, 23, 1), 1");
    volatile LAS unsigned* MISC = (volatile LAS unsigned*)(lds + MISC_OFF);
    const int tid0 = threadIdx.x, wave0 = __builtin_amdgcn_readfirstlane(tid0 >> 6);
    const int G0 = gridDim.x; const int bx0 = blockIdx.x;
    const int vcu = (G0 % 8 == 0) ? (bx0 % 8) * (G0 / 8) + bx0 / 8 : bx0;
    const int gw0 = vcu * NWAVES + wave0, NGW0 = G0 * NWAVES;
    const KA ap0 = (KA)__builtin_amdgcn_kernarg_segment_ptr();
    unsigned char* const ws0 = ap0->ws;
    for (int u = tid0; u < (LDS_BYTES - LDSCTL_OFF) / 4; u += NWAVES * 64) ((LAS unsigned*)(lds + LDSCTL_OFF))[u] = 0u;
    __syncthreads();
    const int lo = ap0->ph_lo, hi = ap0->ph_hi;
    XcdBarrier bar; bar.bar = (unsigned*)(ws0 + WS_CTL) + CW_BAR; bar.x = 0; bar.st = nullptr;
    if (hi - lo > 1) bar = xcd_barrier_post((unsigned*)(ws0 + WS_CTL) + CW_BAR, MISC + 8);
#define PH(p) (lo <= (p) && (p) < hi)
#define SEAM(p) do { if ((p) + 1 < hi) { XcdBarrier b_ = bar; asm volatile("" : "+s"(b_.bar), "+s"(b_.x)); xcd_barrier(b_); } } while (0)
    int pid = 0;
    if (PH(pid)) { const int l0 = 0; PHASE_ENV(); p_prologue(ap, ws, lds, gw, NGW, wave, lane, bx * (NWAVES * 64) + tid, G * NWAVES * 64); SEAM(pid); }
    ++pid;
    for (int l0 = 0; l0 < DEPTH; ++l0) {
        if (PH(pid)) { PHASE_ENV();
            pg8::Gemm g{(const bf16*)(ws + WS_XB), (const bf16*)(ws + WS_WIN) + (size_t)l * INW * DM, NTOK, INW, DM, 0};
            pg8::StaticOrder S; S.init(NTOK, INW, G, bx);
            pg8::EpiIn E{(bf16*)(ws + WS_PROJ), (const float*)(ws + WS_SSQ), (const unsigned*)(ws + WS_ROPEC), QSCALE};
            pg8::gemm_phase<pg8::EpiIn, pg8::StaticOrder, true, true>(lds + RING_OFF, g, S, E);
            { const int NIi = tailcvt_idle_in(G), nbusy = G - NIi;
              if (NIi > 0 && bx >= nbusy) { const int it = l >> 1, base = (it == 0 ? 0 : TAILCVT_K * tailcvt_idle(ctl, G)) + (l & 1) * TAILCVT_KIN * NIi;
                  const MoeCvt get{ap, ws, it, 2 * it + 1, wave}; cvt_pipeline(get, base + (bx - nbusy), NIi, lane, base + TAILCVT_KIN * NIi); } }
            SEAM(pid);
        }
        ++pid;
        if (PH(pid)) { PHASE_ENV();
            const float* sinks = GIN(ap, I_SINK) + l * 8; const float* hnw = GIN(ap, I_HNW) + l * DM; const float* cw = GIN(ap, I_CONVW) + l * 3 * 512;
            const bf16* PROJ = (const bf16*)(ws + WS_PROJ); bf16* Y = (bf16*)(ws + WS_Y);
            LAS float* sc = (LAS float*)(lds + RING_OFF + wave * 4096);
#if ATTN_NAIVE
            for (int it = gw; it < NTOK * 2; it += NGW) attn_naive_item(it >> 1, it & 1, PROJ, sinks, hnw, Y, sc, lane);
#else
            (void)sc;
            for (int u = gw >> 3; u < 512; u += G) attn_unit(u >> 5, (u >> 4) & 1, u & 15, PROJ, sinks, hnw, Y, lds + RING_OFF, wave, lane);
#endif
            for (int it = gw; it < NTOK / 16; it += NGW) conv_item(it * 16, PROJ, cw, hnw, Y, lane);
            SEAM(pid);
        }
        ++pid;
        if (PH(pid)) { PHASE_ENV();
            pg8::Gemm g{(const bf16*)(ws + WS_Y), (const bf16*)(ws + WS_WOUT) + (size_t)l * DM * DM, NTOK, DM, DM, 0};
            pg8::StaticOrder S; S.init(NTOK, DM, G, bx);
            const bool dense = (l & 1) == 0, f8 = UPF8(l >> 1) != 0;
            pg8::EpiRes E{(bf16*)(ws + WS_XB), (dense && f8) ? ws + WS_XF8 : nullptr, (float*)(ws + WS_SSQ), (PG8_LAS float*)(lds + SSQT_OFF), 1.0f, SA_X};
            pg8::gemm_phase<pg8::EpiRes, pg8::StaticOrder, true, true>(lds + RING_OFF, g, S, E);
            SEAM(pid);
        }
        ++pid;
        if ((l0 & 1) == 0) {
            if (PH(pid)) { PHASE_ENV(); const int i = l >> 1;
                pg8::StaticOrder S; S.init(NTOK, 2 * FF, G, bx);
                const bool upf8 = UPF8(i) != 0, dnf8 = DNF8(i) != 0;
#define DENSE_UP_SITE(F8G, F8O) do { \
                    pg8::Gemm g{(F8G) ? (const bf16*)(ws + WS_XF8) : (const bf16*)(ws + WS_XB), (F8G) ? (const bf16*)(ws + WS_WDUP + (size_t)i * 2 * FF * DM * 2) : (const bf16*)(ws + WS_WDUP) + (size_t)i * 2 * FF * DM, NTOK, 2 * FF, DM, 0}; \
                    pg8::EpiUp<F8O> E{ws + WS_ACT, FF, (const float*)(ws + WS_SSQ), (F8G) ? 1.0f / (SA_X * SW_UP) : 1.0f, SA_ACT}; \
                    pg8::gemm_phase<pg8::EpiUp<F8O>, pg8::StaticOrder, true, true, F8G>(lds + RING_OFF, g, S, E); } while (0)
                if ((DENSE_UP_F8 & DENSE_DN_F8) != 0 && upf8 && dnf8) DENSE_UP_SITE(true, true);
                if ((DENSE_UP_F8 & ~DENSE_DN_F8 & 3) != 0 && upf8 && !dnf8) DENSE_UP_SITE(true, false);
                if ((~DENSE_UP_F8 & DENSE_DN_F8 & 3) != 0 && !upf8 && dnf8) DENSE_UP_SITE(false, true);
                if ((~DENSE_UP_F8 & ~DENSE_DN_F8 & 3) != 0 && !upf8 && !dnf8) DENSE_UP_SITE(false, false);
#undef DENSE_UP_SITE
                SEAM(pid);
            }
            ++pid;
            if (PH(pid)) { PHASE_ENV(); const int i = l >> 1;
                pg8::StaticOrder S; S.init(NTOK, DM, G, bx);
                if (DENSE_DN_F8 != 0 && (DENSE_DN_F8 == 3 || DNF8(i))) {
                    pg8::Gemm g{(const bf16*)(ws + WS_ACT), (const bf16*)(ws + WS_WDDN + (size_t)i * DM * FF * 2), NTOK, DM, FF, 0};
                    pg8::EpiRes E{(bf16*)(ws + WS_XB), nullptr, (float*)(ws + WS_SSQ), (PG8_LAS float*)(lds + SSQT_OFF), 1.0f / (SA_ACT * SW_DN), 0.f};
                    pg8::gemm_phase<pg8::EpiRes, pg8::StaticOrder, true, true, true>(lds + RING_OFF, g, S, E);
                } else if (DENSE_DN_F8 != 3) {
                    pg8::Gemm g{(const bf16*)(ws + WS_ACT), (const bf16*)(ws + WS_WDDN) + (size_t)i * DM * FF, NTOK, DM, FF, 0};
                    pg8::EpiRes E{(bf16*)(ws + WS_XB), nullptr, (float*)(ws + WS_SSQ), (PG8_LAS float*)(lds + SSQT_OFF), 1.0f, 0.f};
                    pg8::gemm_phase<pg8::EpiRes, pg8::StaticOrder, true, true, false>(lds + RING_OFF, g, S, E);
                }
                SEAM(pid);
            }
            ++pid;
        } else {
            if (PH(pid)) { PHASE_ENV(); const int i = l >> 1;
                p_router(ap, ws, lds, ctl, (const bf16*)(ws + WS_XB), l, i, i, wave, lane, tid, G);
                p_moe_weights(ap, ws, lds, i, gw, NGW, wave, lane, (i == 1 ? TAILCVT_K * tailcvt_idle(ctl, G) : 0) + 2 * TAILCVT_KIN * tailcvt_idle_in(G));
                SEAM(pid);
            }
            ++pid;
            if (PH(pid)) { PHASE_ENV(); const int i = l >> 1;
                const MoeMeta mm = moe_meta(ctl, i);
                pg8::Gemm g{(const bf16*)(ws + WS_XS), (const bf16*)(ws + WS_WMUP + (size_t)i * MOE_SET_UP), mm.ntiles * 256, 2 * FF, DM, (size_t)2 * FF * DM};
                pg8::MoeOrder S; S.init(mm.ntiles * 256, 2 * FF, G, bx); S.acap = NTOK / 256;
#pragma unroll
                for (int e = 0; e < 8; ++e) S.tend[e] = mm.tend[e];
                pg8::EpiUp<true> E{ws + WS_ACT, FF, nullptr, 1.0f / (SA_X * SW_UP), SA_ACT};
                pg8::gemm_phase<pg8::EpiUp<true>, pg8::MoeOrder, true, true, true>(lds + RING_OFF, g, S, E);
                SEAM(pid);
            }
            ++pid;
            if (PH(pid)) { PHASE_ENV(); const int i = l >> 1;
                const MoeMeta mm = moe_meta(ctl, i);
                pg8::Gemm g{(const bf16*)(ws + WS_ACT), (const bf16*)(ws + WS_WMDN + (size_t)i * MOE_SET_DN), mm.ntiles * 256, DM, FF, (size_t)DM * FF};
                pg8::MoeOrder S; S.init(mm.ntiles * 256, DM, G, bx); S.acap = 0;
#pragma unroll
                for (int e = 0; e < 8; ++e) S.tend[e] = mm.tend[e];
                pg8::EpiYs E{ws + WS_YS, DM, S_YS / (SA_ACT * SW_DN)};
                pg8::gemm_phase<pg8::EpiYs, pg8::MoeOrder, true, true, true>(lds + RING_OFF, g, S, E);
                if (i == 0) { const int NI = tailcvt_idle(ctl, G), nbusy = G - NI;
                    if (NI > 0 && bx >= nbusy) { const MoeCvt get{ap, ws, 1, 3, wave}; cvt_pipeline(get, bx - nbusy, NI, lane, TAILCVT_K * NI); } }
                SEAM(pid);
            }
            ++pid;
            if (PH(pid)) { PHASE_ENV(); const int i = l >> 1; p_combine(ap, ws, ctl, (bf16*)(ws + WS_XB), GOUT(ap), (float*)(ws + WS_SSQ), i, l == DEPTH - 1, gw, NGW, lane); SEAM(pid); }
            ++pid;
        }
    }
#undef PH
#undef SEAM
}
constexpr int N_PHASES = 1 + 2 * (3 + 2) + 2 * (3 + 4);

extern "C" void kernel_launch(void* const* d_in, const int* in_sizes, int n_in, void* d_out, int out_size, void* d_ws, size_t ws_size, hipStream_t stream) {
    static int grid = 0;
    if (grid == 0) {
        if (n_in != 17 || out_size != NTOK * DM || ws_size < WS_END) { fprintf(stderr, "kernel_launch: unexpected shapes (n_in %d, out %d, ws %zu < %zu); nothing launched\n", n_in, out_size, ws_size, (size_t)WS_END); grid = -1; return; }
        int dev = 0, cus = 0, per_cu = 0;
        if (hipGetDevice(&dev) != hipSuccess || hipDeviceGetAttribute(&cus, hipDeviceAttributeMultiprocessorCount, dev) != hipSuccess) { grid = -1; return; }
        if (hipFuncSetAttribute((const void*)fwd_kernel, hipFuncAttributeMaxDynamicSharedMemorySize, LDS_BYTES) != hipSuccess) { fprintf(stderr, "kernel_launch: hipFuncSetAttribute failed\n"); grid = -1; return; }
        if (hipOccupancyMaxActiveBlocksPerMultiprocessor(&per_cu, (const void*)fwd_kernel, NWAVES * 64, LDS_BYTES) != hipSuccess || per_cu < 1) fprintf(stderr, "kernel_launch: occupancy query reports %d blocks per CU\n", per_cu);
        (void)hipGetLastError();
        if ((NTOK + cus - 1) / cus > 128) { fprintf(stderr, "kernel_launch: the router phase keeps 128 token rows per workgroup in LDS: needs >= 256 CUs (got %d); nothing launched\n", cus); grid = -1; return; }
        grid = cus;
    }
    if (grid < 0) return;
    if (hipMemsetAsync((char*)d_ws + WS_CTL, 0, CTL_ZERO_BYTES, stream) != hipSuccess) return;
    Args a{};
    for (int i = 0; i < 17; ++i) a.in[i] = (const float*)d_in[i];
    a.out = (float*)d_out; a.ws = (unsigned char*)d_ws;
#if MK_PER_PHASE
    for (int p = 0; p < N_PHASES; ++p) { a.ph_lo = p; a.ph_hi = p + 1; hipLaunchKernelGGL(fwd_kernel, dim3(grid), dim3(NWAVES * 64), LDS_BYTES, stream, a); }
#else
    a.ph_lo = 0; a.ph_hi = N_PHASES;
    hipLaunchKernelGGL(fwd_kernel, dim3(grid), dim3(NWAVES * 64), LDS_BYTES, stream, a);
#endif
}
```

```cpp
#include <hip/hip_runtime.h>
#include <cstdio>
#include <cstdint>
#include <cstddef>
namespace pg8 {
#define PG8_LAS __attribute__((address_space(3)))
typedef unsigned short bf16_t;
typedef short bf16x8 __attribute__((ext_vector_type(8)));
typedef float f32x4 __attribute__((ext_vector_type(4)));
typedef unsigned u32x4 __attribute__((ext_vector_type(4)));
constexpr int BM = 256, BK = 64, HALF = 128, HTB = HALF * BK * 2  , STAGE_BYTES = 8 * HTB, NXCD = 8, WGM = 8;

__host__ __device__ __forceinline__ int lds_byte(int r, int c) { const int st = (r >> 4) * 2 + (c >> 5), rr = r & 15, cc = c & 31, ob = rr * 64 + cc * 2; return st * 1024 + (ob ^ (((ob >> 9) & 1) << 5)); }
__host__ __device__ __forceinline__ void stage_rc(int b, int& R, int& C) { const int st = b / 1024, sb = b % 1024, swz = sb ^ (((sb >> 9) & 1) << 5); R = (st >> 1) * 16 + swz / 64; C = (st & 1) * 32 + (swz % 64) / 2; }
__host__ __device__ __forceinline__ int perm32(int rho) { const int n = rho >> 4, i = rho & 15; return 8 * (i >> 2) + 4 * n + (i & 3); }

struct Unit { int pm, pn, pe, pa; };
struct Gemm { const bf16_t* A; const bf16_t* Bt; int M, N, K; size_t estep; };

struct StaticOrder {
    int nM, nN, nwg, G, c;
    __host__ __device__ void init(int M, int N, int G_, int c_) { nM = M / BM; nN = N / BM; nwg = nM * nN; G = G_; c = c_; }
    __host__ __device__ bool next(int i, Unit& u) const {
        const long L = (long)i * G + c; if (L >= nwg) return false;
        int wgid = (int)L; { const int q = nwg / NXCD, r = nwg % NXCD, xcd = wgid % NXCD, off = wgid / NXCD; wgid = (xcd < r ? xcd * (q + 1) : r * (q + 1) + (xcd - r) * q) + off; }
        const int nig = WGM * nN, gid = wgid / nig, fm = gid * WGM, gsz = (nM - fm) < WGM ? (nM - fm) : WGM;
        u.pm = fm + ((wgid % nig) % gsz); u.pn = (wgid % nig) / gsz; u.pe = 0; u.pa = u.pm; return true;
    }
    __device__ __forceinline__ void a_ready(const Unit&) const {}
    __device__ __forceinline__ void done(const Unit&) const {}
};

__device__ __forceinline__ unsigned cvt_pk_bf16(float lo, float hi) { unsigned r; asm volatile("v_cvt_pk_bf16_f32 %0, %1, %2" : "=v"(r) : "v"(lo), "v"(hi)); return r; }
typedef float f32x2 __attribute__((ext_vector_type(2)));

typedef unsigned u32x2 __attribute__((ext_vector_type(2)));
constexpr float NORM_EPS = 1e-5f;
__device__ __forceinline__ float row_rstd(const float* ssq, int row) {
    const f32x4 s = *(const f32x4*)(ssq + (size_t)row * 4);
    return __builtin_amdgcn_rsqf(((s[0] + s[1]) + (s[2] + s[3])) * (1.0f / 1024.0f) + NORM_EPS);
}
__device__ __forceinline__ float silu_mul(float g, float u) {
    const float e = __builtin_amdgcn_exp2f(-1.4426950408889634f * g);
    return g * u * __builtin_amdgcn_rcpf(1.0f + e);
}
__device__ __forceinline__ float h_lo(unsigned w) { return (float)__builtin_bit_cast(_Float16, (unsigned short)(w & 0xffffu)); }
__device__ __forceinline__ float h_hi(unsigned w) { return (float)__builtin_bit_cast(_Float16, (unsigned short)(w >> 16)); }
struct EpiIn {
    static constexpr bool PERM = true, AFTER_DRAIN = false, FKOK = false; static constexpr int NST = 0;
    bf16_t* P; const float* ssq; const unsigned* rcs; float qscale, ascale;
    __device__ __forceinline__ void operator()(const f32x4 (&acc)[2][2][4][2], const Unit& u, int wr, int wc, int fr, int fq) const {
        const int row0 = u.pm * BM + wr * 64 + fr;
        const int colb = u.pn * BM + wc * 64 + 8 * fq;
        const bool rope = (u.pn < 2) || (u.pn == 2 && wc < 2);
        const float sc = (u.pn < 2) ? qscale : 1.0f;
        u32x4 cs[4][2], wo[4], vo[4]; f32x4 sv[4];
#pragma unroll
        for (int ai = 0; ai < 2; ++ai) {
#pragma unroll
            for (int m = 0; m < 4; ++m) sv[m] = *(const f32x4*)(ssq + (size_t)(row0 + ai * HALF + m * 16) * 4);
            if (rope) {
#pragma unroll
                for (int m = 0; m < 4; ++m) { const unsigned* cp = rcs + (size_t)(row0 + ai * HALF + m * 16) * 32 + 8 * fq; cs[m][0] = *(const u32x4*)cp; cs[m][1] = *(const u32x4*)(cp + 4); }
            }
            if (ai == 1) {
#pragma unroll
                for (int m = 0; m < 4; ++m) { bf16_t* rp = P + (size_t)(row0 + m * 16) * 2304 + colb; *(u32x4*)rp = wo[m]; *(u32x4*)(rp + 32) = vo[m]; }
            }
#pragma unroll
            for (int m = 0; m < 4; ++m) {
                const float rs = __builtin_amdgcn_rsqf(((sv[m][0] + sv[m][1]) + (sv[m][2] + sv[m][3])) * (1.0f / 1024.0f) + NORM_EPS) * ascale;
                f32x4 a0 = acc[ai][0][m][0] * rs, a1 = acc[ai][0][m][1] * rs, b0 = acc[ai][1][m][0] * rs, b1 = acc[ai][1][m][1] * rs;
                if (rope) {
                    const u32x4 q0 = cs[m][0], q1 = cs[m][1];
                    const f32x4 c0 = {h_lo(q0.x), h_lo(q0.y), h_lo(q0.z), h_lo(q0.w)}, s0 = {h_hi(q0.x), h_hi(q0.y), h_hi(q0.z), h_hi(q0.w)};
                    const f32x4 c1 = {h_lo(q1.x), h_lo(q1.y), h_lo(q1.z), h_lo(q1.w)}, s1 = {h_hi(q1.x), h_hi(q1.y), h_hi(q1.z), h_hi(q1.w)};
                    const f32x4 o0 = (a0 * c0 - b0 * s0) * sc, o1 = (a1 * c1 - b1 * s1) * sc, p0 = (b0 * c0 + a0 * s0) * sc, p1 = (b1 * c1 + a1 * s1) * sc;
                    a0 = o0; a1 = o1; b0 = p0; b1 = p1;
                }
                u32x4 w; w.x = cvt_pk_bf16(a0[0], a0[1]); w.y = cvt_pk_bf16(a0[2], a0[3]); w.z = cvt_pk_bf16(a1[0], a1[1]); w.w = cvt_pk_bf16(a1[2], a1[3]);
                u32x4 v; v.x = cvt_pk_bf16(b0[0], b0[1]); v.y = cvt_pk_bf16(b0[2], b0[3]); v.z = cvt_pk_bf16(b1[0], b1[1]); v.w = cvt_pk_bf16(b1[2], b1[3]);
                wo[m] = w; vo[m] = v;
            }
        }
#pragma unroll
        for (int m = 0; m < 4; ++m) { bf16_t* rp = P + (size_t)(row0 + HALF + m * 16) * 2304 + colb; *(u32x4*)rp = wo[m]; *(u32x4*)(rp + 32) = vo[m]; }
    }
};
__device__ __forceinline__ unsigned pk4_fp8(float a, float b, float c, float d) {
    unsigned w; asm("v_cvt_pk_fp8_f32 %0, %1, %2" : "=v"(w) : "v"(a), "v"(b)); asm("v_cvt_pk_fp8_f32 %0, %1, %2 op_sel:[0,0,1]" : "+v"(w) : "v"(c), "v"(d)); return w;
}
__device__ __forceinline__ float bf_lo(unsigned w) { return __builtin_bit_cast(float, w << 16); }
__device__ __forceinline__ float bf_hi(unsigned w) { return __builtin_bit_cast(float, w & 0xffff0000u); }
struct EpiRes {
    static constexpr bool PERM = true, AFTER_DRAIN = false, FKOK = true; static constexpr int NST = 0;
    bf16_t* XB; unsigned char* XF; float* ssq; PG8_LAS float* tbl; float cs, fs;
    __device__ __forceinline__ void operator()(const f32x4 (&acc)[2][2][4][2], const Unit& u, int wr, int wc, int fr, int fq) const {
        const int col0 = u.pn * BM + wc * 32 + 8 * fq;
        u32x4 rin[2][4][2];
#pragma unroll
        for (int ai = 0; ai < 2; ++ai)
#pragma unroll
            for (int m = 0; m < 4; ++m)
#pragma unroll
                for (int bj = 0; bj < 2; ++bj) rin[ai][m][bj] = *(const u32x4*)(XB + (size_t)(u.pm * BM + ai * HALF + wr * 64 + m * 16 + fr) * 1024 + col0 + bj * HALF);
#pragma unroll
        for (int ai = 0; ai < 2; ++ai)
#pragma unroll
            for (int m = 0; m < 4; ++m) {
                const int rowl = ai * HALF + wr * 64 + m * 16 + fr; const size_t off = (size_t)(u.pm * BM + rowl) * 1024 + col0; float sq = 0.f;
#pragma unroll
                for (int bj = 0; bj < 2; ++bj) {
                    const size_t o = off + bj * HALF;
                    const u32x4 rw = rin[ai][m][bj];
                    const f32x4 r0 = {bf_lo(rw.x), bf_hi(rw.x), bf_lo(rw.y), bf_hi(rw.y)}, r1 = {bf_lo(rw.z), bf_hi(rw.z), bf_lo(rw.w), bf_hi(rw.w)};
                    const f32x4 x0 = r0 + acc[ai][bj][m][0] * cs, x1 = r1 + acc[ai][bj][m][1] * cs;
                    { u32x4 w; w.x = cvt_pk_bf16(x0[0], x0[1]); w.y = cvt_pk_bf16(x0[2], x0[3]); w.z = cvt_pk_bf16(x1[0], x1[1]); w.w = cvt_pk_bf16(x1[2], x1[3]); *(u32x4*)(XB + o) = w; }
                    if (XF) { u32x2 w; w.x = pk4_fp8(x0[0] * fs, x0[1] * fs, x0[2] * fs, x0[3] * fs); w.y = pk4_fp8(x1[0] * fs, x1[1] * fs, x1[2] * fs, x1[3] * fs); *(u32x2*)(XF + o) = w; }
                    sq += ((x0[0] * x0[0] + x0[1] * x0[1]) + (x0[2] * x0[2] + x0[3] * x0[3])) + ((x1[0] * x1[0] + x1[1] * x1[1]) + (x1[2] * x1[2] + x1[3] * x1[3]));
                }
                sq += __shfl_xor(sq, 16); sq += __shfl_xor(sq, 32);
                if (fq == 0) tbl[rowl * 4 + wc] = sq;
            }
        asm volatile("s_waitcnt lgkmcnt(0)" ::: "memory"); __builtin_amdgcn_s_barrier(); asm volatile("" ::: "memory");
        const int lane = fq * 16 + fr;
        if (lane < 32) {
            const int rowl = (wc >> 1) * HALF + wr * 64 + (wc & 1) * 32 + lane;
            const f32x4 t = *(const PG8_LAS f32x4*)(tbl + rowl * 4);
            ssq[(size_t)(u.pm * BM + rowl) * 4 + u.pn] = (t[0] + t[1]) + (t[2] + t[3]);
        }
    }
};
template <bool F8OUT> struct EpiUp {
    static constexpr bool PERM = true, AFTER_DRAIN = false, FKOK = true; static constexpr int NST = 8;
    void* O; int ldc; const float* ssq; float cs, fs;
    static __device__ __forceinline__ float sm(float ag, float au, float k1, float ik2) { return (ag * au) * __builtin_amdgcn_rcpf(__builtin_fmaf(__builtin_amdgcn_exp2f(ag * k1), ik2, ik2)); }
    typedef float v2f __attribute__((ext_vector_type(2)));
    static __device__ __forceinline__ v2f sm2(v2f ag, v2f au, float k1, float ik2) {
        const v2f K1 = {k1, k1}, K2 = {ik2, ik2}; const v2f t = ag * K1; v2f e; e.x = __builtin_amdgcn_exp2f(t.x); e.y = __builtin_amdgcn_exp2f(t.y);
        const v2f d = __builtin_elementwise_fma(e, K2, K2); v2f r; r.x = __builtin_amdgcn_rcpf(d.x); r.y = __builtin_amdgcn_rcpf(d.y); return (ag * au) * r; }
    static __device__ __forceinline__ v2f lo2(f32x4 v) { return __builtin_shufflevector(v, v, 0, 1); }
    static __device__ __forceinline__ v2f hi2(f32x4 v) { return __builtin_shufflevector(v, v, 2, 3); }
    __device__ __forceinline__ void operator()(const f32x4 (&acc)[2][2][4][2], const Unit& u, int wr, int wc, int fr, int fq) const {
        const int row0 = u.pm * BM + wr * 64 + fr, col0 = u.pn * HALF + wc * 32 + 8 * fq;
        float rsv[2][4];
#pragma unroll
        for (int ai = 0; ai < 2; ++ai)
#pragma unroll
            for (int m = 0; m < 4; ++m) rsv[ai][m] = ssq ? row_rstd(ssq, row0 + ai * HALF + m * 16) : 1.0f;
#pragma unroll
        for (int ai = 0; ai < 2; ++ai)
#pragma unroll
            for (int m = 0; m < 4; ++m) {
                const int row = row0 + ai * HALF + m * 16;
                const float rs = rsv[ai][m] * cs, k1 = -1.4426950408889634f * rs, k2 = __builtin_amdgcn_rcpf(rs * rs * (F8OUT ? fs : 1.0f));
                const f32x4 g0 = acc[ai][0][m][0], g1 = acc[ai][0][m][1], u0 = acc[ai][1][m][0], u1 = acc[ai][1][m][1];
                if (F8OUT) {
                    const v2f a0 = sm2(lo2(g0), lo2(u0), k1, k2), a1 = sm2(hi2(g0), hi2(u0), k1, k2), a2 = sm2(lo2(g1), lo2(u1), k1, k2), a3 = sm2(hi2(g1), hi2(u1), k1, k2);
                    u32x2 w; w.x = pk4_fp8(a0.x, a0.y, a1.x, a1.y); w.y = pk4_fp8(a2.x, a2.y, a3.x, a3.y);
                    *(u32x2*)((unsigned char*)O + (size_t)row * ldc + col0) = w;
                } else {
                    u32x4 w;
                    const v2f a0 = sm2(lo2(g0), lo2(u0), k1, k2), a1 = sm2(hi2(g0), hi2(u0), k1, k2), a2 = sm2(lo2(g1), lo2(u1), k1, k2), a3 = sm2(hi2(g1), hi2(u1), k1, k2);
                    w.x = cvt_pk_bf16(a0.x, a0.y); w.y = cvt_pk_bf16(a1.x, a1.y); w.z = cvt_pk_bf16(a2.x, a2.y); w.w = cvt_pk_bf16(a3.x, a3.y);
                    *(u32x4*)((bf16_t*)O + (size_t)row * ldc + col0) = w;
                }
            }
    }
};
struct EpiYs {
    static constexpr bool PERM = true, AFTER_DRAIN = false, FKOK = true; static constexpr int NST = 16;
    unsigned char* O; int ldc; float cs;
    __device__ __forceinline__ void operator()(const f32x4 (&acc)[2][2][4][2], const Unit& u, int wr, int wc, int fr, int fq) const {
        const int row0 = u.pm * BM + wr * 64 + fr, col0 = u.pn * BM + wc * 32 + 8 * fq;
#pragma unroll
        for (int ai = 0; ai < 2; ++ai)
#pragma unroll
            for (int m = 0; m < 4; ++m) { unsigned char* rowp = O + (size_t)(row0 + ai * HALF + m * 16) * ldc + col0;
#pragma unroll
                for (int bj = 0; bj < 2; ++bj) { const f32x4 v0 = acc[ai][bj][m][0] * cs, v1 = acc[ai][bj][m][1] * cs;
                    u32x2 w; w.x = pk4_fp8(v0[0], v0[1], v0[2], v0[3]); w.y = pk4_fp8(v1[0], v1[1], v1[2], v1[3]);
                    *(u32x2*)(rowp + bj * HALF) = w; } }
    }
};
struct MoeOrder : StaticOrder {
    int tend[8]; int acap;
    __device__ __forceinline__ bool next(int i, Unit& u) const {
        if (!StaticOrder::next(i, u)) return false;
        int e = 0, ts = 0;
#pragma unroll
        for (int j = 0; j < 7; ++j) { const bool ge = u.pm >= tend[j]; e += ge ? 1 : 0; ts = ge ? tend[j] : ts; }
        u.pe = __builtin_amdgcn_readfirstlane(e); u.pm = __builtin_amdgcn_readfirstlane(u.pm); u.pn = __builtin_amdgcn_readfirstlane(u.pn);
        u.pa = acap ? __builtin_amdgcn_readfirstlane(e * acap + (u.pm - ts)) : u.pm; return true;
    }
};

__device__ __forceinline__ void pg8_glds(const char* sbase, unsigned voff, unsigned lds_dst) {
    unsigned keep; asm volatile("s_mov_b32 %0, m0\n\ts_mov_b32 m0, %3\n\ts_nop 2\n\tglobal_load_lds_dwordx4 %1, %2\n\ts_mov_b32 m0, %0" : "=&s"(keep) : "v"(voff), "s"(sbase), "s"(lds_dst) : "memory"); }
#ifndef PG8_OPT_Z
#define PG8_OPT_Z 1
#endif
#ifndef PG8_OPT_NEXT
#define PG8_OPT_NEXT 1
#endif
template <int N> __device__ __forceinline__ void pg8_waitv() { asm volatile("s_waitcnt vmcnt(%0)" :: "n"(N) : "memory"); }
template <class Epi, class Sched, bool ALIGN_EPI = false, bool SP2 = false, bool F8 = false>
__device__ __forceinline__ void gemm_phase(PG8_LAS unsigned char* lds, const Gemm g, const Sched& S, const Epi& E) {
    int tid_ = threadIdx.x; asm volatile("" : "+v"(tid_));
    const int tid = tid_, wid = __builtin_amdgcn_readfirstlane(tid >> 6), lane = tid & 63, wr = wid >> 2, wc = wid & 3, fr = lane & 15, fq = lane >> 4;
    const int K = F8 ? (g.K >> 1) : g.K, nt = K / BK;
    unsigned voffA[2], voffB[2];
#pragma unroll
    for (int i = 0; i < 2; ++i) { int R, C; stage_rc(tid * 16 + i * 8192, R, C); const int Rb = Epi::PERM ? ((R & ~31) + perm32(R & 31)) : R;
        voffA[i] = (unsigned)(R * K + C) * 2u; voffB[i] = (unsigned)(Rb * K + C) * 2u; }
    const size_t kstep = (size_t)(BK * 2);
    const size_t hstep = (size_t)HALF * K * 2;
    const size_t tstep = 2 * hstep;
    const unsigned ldsb = (unsigned)(size_t)lds;
    const unsigned ldsw = (unsigned)wid * 1024u;
    const int aoff = lds_byte(wr * 64 + fr, fq * 8), boff = lds_byte(wc * 32 + fr, fq * 8);
#define PG8_SA(b, h) (((b) * 2 + (h)) * HTB)
#define PG8_SB(b, h) ((4 + (b) * 2 + (h)) * HTB)
#define PG8_STAGE(bufoff, gbase, voff) do { _Pragma("unroll") for (int _i = 0; _i < 2; ++_i) \
        pg8_glds((const char*)(gbase), (voff)[_i], ldsb + (unsigned)((bufoff) + _i * 8192) + ldsw); } while (0)
#define PG8_LDA(dst, b, h) do { _Pragma("unroll") for (int m = 0; m < 4; ++m) _Pragma("unroll") for (int k = 0; k < 2; ++k) dst[m][k] = *(const PG8_LAS bf16x8*)(lds + PG8_SA(b, h) + aoff + m * 2048 + k * 1024); } while (0)
#define PG8_LDB(dst, b, h) do { _Pragma("unroll") for (int n = 0; n < 2; ++n) _Pragma("unroll") for (int k = 0; k < 2; ++k) dst[n][k] = *(const PG8_LAS bf16x8*)(lds + PG8_SB(b, h) + boff + n * 2048 + k * 1024); } while (0)
#define PG8_MMA(ai, bj, At, Bt, Z) do { __builtin_amdgcn_s_setprio(1); _Pragma("unroll") for (int m = 0; m < 4; ++m) _Pragma("unroll") for (int n = 0; n < 2; ++n) { \
        if constexpr (F8) { typedef int v8i_t __attribute__((ext_vector_type(8))); typedef int v4i_t __attribute__((ext_vector_type(4))); \
            const v4i_t b0_ = __builtin_bit_cast(v4i_t, Bt[n][0]), b1_ = __builtin_bit_cast(v4i_t, Bt[n][1]), a0_ = __builtin_bit_cast(v4i_t, At[m][0]), a1_ = __builtin_bit_cast(v4i_t, At[m][1]); \
            const v8i_t bw_ = {b0_[0], b0_[1], b0_[2], b0_[3], b1_[0], b1_[1], b1_[2], b1_[3]}, aw_ = {a0_[0], a0_[1], a0_[2], a0_[3], a1_[0], a1_[1], a1_[2], a1_[3]}; \
            if constexpr (Z) asm volatile("v_mfma_f32_16x16x128_f8f6f4 %0, %1, %2, 0" : "=v"(acc[ai][bj][m][n]) : "v"(bw_), "v"(aw_)); \
            else asm volatile("v_mfma_f32_16x16x128_f8f6f4 %0, %1, %2, %0" : "+v"(acc[ai][bj][m][n]) : "v"(bw_), "v"(aw_)); } \
        else { _Pragma("unroll") for (int k = 0; k < 2; ++k) acc[ai][bj][m][n] = __builtin_amdgcn_mfma_f32_16x16x32_bf16(Bt[n][k], At[m][k], acc[ai][bj][m][n], 0, 0, 0); } } \
        __builtin_amdgcn_s_setprio(0); } while (0)
#define PG8_WAIT_V(n) asm volatile("s_waitcnt vmcnt(" #n ")" ::: "memory")
#define PG8_WAIT_L(n) asm volatile("s_waitcnt lgkmcnt(" #n ")" ::: "memory")
#define PG8_BAR __builtin_amdgcn_s_barrier()
#define PG8_SCHED __builtin_amdgcn_sched_barrier(0)
    constexpr bool FK = F8 && SP2 && Epi::FKOK;
    constexpr bool ZF = FK && (PG8_OPT_Z != 0);
    Unit cur, nxt; int ui = 0;
    if (!S.next(0, cur)) return;
    f32x4 acc[2][2][4][2];
#pragma unroll
    for (int a = 0; a < 2; ++a)
#pragma unroll
        for (int b = 0; b < 2; ++b)
#pragma unroll
            for (int m = 0; m < 4; ++m)
#pragma unroll
                for (int n = 0; n < 2; ++n) acc[a][b][m][n] = (f32x4){0.f, 0.f, 0.f, 0.f};
    bf16x8 At[4][2], B0[2][2], B1[2][2];
    const char* cA = (const char*)g.A + (size_t)cur.pa * tstep; const char* cB = (const char*)g.Bt + (size_t)cur.pe * g.estep + (size_t)cur.pn * tstep;
    S.a_ready(cur);
    if constexpr (SP2) {
        PG8_STAGE(PG8_SB(0, 0), cB, voffB); PG8_STAGE(PG8_SB(0, 1), cB + hstep, voffB); PG8_STAGE(PG8_SA(0, 0), cA, voffA); PG8_STAGE(PG8_SA(0, 1), cA + hstep, voffA);
        if (wr == 1) PG8_BAR;
        PG8_WAIT_V(2); PG8_BAR;
        PG8_STAGE(PG8_SB(1, 0), cB + kstep, voffB); PG8_STAGE(PG8_SA(1, 0), cA + kstep, voffA); PG8_STAGE(PG8_SB(1, 1), cB + hstep + kstep, voffB);
        PG8_WAIT_V(6); PG8_BAR;
    } else {
        PG8_STAGE(PG8_SB(0, 0), cB, voffB); PG8_STAGE(PG8_SA(0, 0), cA, voffA); PG8_STAGE(PG8_SB(0, 1), cB + hstep, voffB); PG8_STAGE(PG8_SA(0, 1), cA + hstep, voffA);
        if (wr == 1) PG8_BAR;
        PG8_WAIT_V(4); PG8_BAR;
        PG8_STAGE(PG8_SB(1, 0), cB + kstep, voffB); PG8_STAGE(PG8_SA(1, 0), cA + kstep, voffA); PG8_STAGE(PG8_SB(1, 1), cB + hstep + kstep, voffB);
        PG8_WAIT_V(6); PG8_BAR;
    }
    for (;;) {
        bool has_next = false; const char* nA = cA; const char* nB = cB;
#define PG8_NEXT do { has_next = S.next(ui + 1, nxt); nA = has_next ? (const char*)g.A + (size_t)nxt.pa * tstep : cA; nB = has_next ? (const char*)g.Bt + (size_t)nxt.pe * g.estep + (size_t)nxt.pn * tstep : cB; } while (0)
        if constexpr (PG8_OPT_NEXT == 0 || !FK) PG8_NEXT;
#pragma unroll 1
        for (int t = 0; t < nt; t += 2) {
            const bool last = (t == nt - 2);
            const char* a1 = cA + (size_t)(t + 1) * kstep;
            const char* a2 = last ? nA : cA + (size_t)(t + 2) * kstep; const char* b2 = last ? nB : cB + (size_t)(t + 2) * kstep;
            const char* a3 = a2 + kstep; const char* b3 = b2 + kstep;
            if (last && has_next) S.a_ready(nxt);
            if constexpr (SP2) {
#define PG8_KT(b, AX, BN, AN, Z, FIRST) do { \
            PG8_LDB(B0, b, 0); PG8_LDB(B1, b, 1); PG8_SCHED; PG8_LDA(At, b, 0); PG8_STAGE(PG8_SA(1 - (b), 1), (AX) + hstep, voffA); \
            if (FIRST && ui > 0) pg8_waitv<8 + Epi::NST>(); else pg8_waitv<8>(); \
            PG8_WAIT_L(0); PG8_BAR; PG8_MMA(0, 0, At, B0, Z); if constexpr (FIRST && PG8_OPT_NEXT == 1) PG8_NEXT; PG8_MMA(0, 1, At, B1, Z); PG8_BAR; PG8_SCHED; \
            PG8_LDA(At, b, 1); PG8_STAGE(PG8_SB(b, 0), BN, voffB); PG8_STAGE(PG8_SB(b, 1), (BN) + hstep, voffB); PG8_STAGE(PG8_SA(b, 0), AN, voffA); \
            if (FIRST && ui > 0) pg8_waitv<8 + Epi::NST>(); else pg8_waitv<8>(); \
            PG8_WAIT_L(0); PG8_BAR; PG8_MMA(1, 0, At, B0, Z); PG8_MMA(1, 1, At, B1, Z); PG8_BAR; PG8_SCHED; } while (0)
            if constexpr (FK) { if (t == 0) PG8_KT(0, a1, b2, a2, ZF, true); else PG8_KT(0, a1, b2, a2, false, false); }
            else PG8_KT(0, a1, b2, a2, false, false);
            PG8_KT(1, a2, b3, a3, false, false);
            } else {
            if (t == 0) PG8_NEXT;
            PG8_LDB(B0, 0, 0); PG8_SCHED; PG8_LDA(At, 0, 0); PG8_STAGE(PG8_SA(1, 1), a1 + hstep, voffA);
            PG8_WAIT_L(8); PG8_BAR; PG8_WAIT_L(0); PG8_MMA(0, 0, At, B0, false); PG8_BAR; PG8_SCHED;
            PG8_LDB(B1, 0, 1); PG8_STAGE(PG8_SB(0, 0), b2, voffB);
            PG8_BAR; PG8_WAIT_L(0); PG8_MMA(0, 1, At, B1, false); PG8_BAR;
            PG8_LDA(At, 0, 1); PG8_STAGE(PG8_SA(0, 0), a2, voffA);
            PG8_BAR; PG8_WAIT_L(0); PG8_MMA(1, 0, At, B0, false); PG8_BAR; PG8_SCHED;
            PG8_STAGE(PG8_SB(0, 1), b2 + hstep, voffB);
            PG8_WAIT_V(6); PG8_BAR; PG8_MMA(1, 1, At, B1, false); PG8_BAR;
            PG8_LDB(B0, 1, 0); PG8_SCHED; PG8_LDA(At, 1, 0); PG8_STAGE(PG8_SA(0, 1), a2 + hstep, voffA);
            PG8_WAIT_L(8); PG8_BAR; PG8_WAIT_L(0); PG8_MMA(0, 0, At, B0, false); PG8_BAR; PG8_SCHED;
            PG8_LDB(B1, 1, 1); PG8_STAGE(PG8_SB(1, 0), b3, voffB);
            PG8_BAR; PG8_WAIT_L(0); PG8_MMA(0, 1, At, B1, false); PG8_BAR;
            PG8_LDA(At, 1, 1); PG8_STAGE(PG8_SA(1, 0), a3, voffA);
            PG8_BAR; PG8_WAIT_L(0); PG8_MMA(1, 0, At, B0, false); PG8_BAR; PG8_SCHED;
            PG8_STAGE(PG8_SB(1, 1), b3 + hstep, voffB);
            PG8_WAIT_V(6); PG8_BAR; PG8_MMA(1, 1, At, B1, false); PG8_BAR;
            }
        }
        if constexpr (ALIGN_EPI) { if (wr == 0) PG8_BAR; }
        if constexpr (F8) asm volatile("s_nop 15\n\ts_nop 7" ::: "memory");
        if constexpr (!Epi::AFTER_DRAIN) { int fr_ = fr, fq_ = fq; asm volatile("" : "+v"(fr_), "+v"(fq_)); E(acc, cur, wr, wc, fr_, fq_); S.done(cur); }
        if (!has_next) break;
        if constexpr (!ZF) {
#pragma unroll
        for (int a = 0; a < 2; ++a)
#pragma unroll
            for (int b = 0; b < 2; ++b)
#pragma unroll
                for (int m = 0; m < 4; ++m)
#pragma unroll
                    for (int n = 0; n < 2; ++n) acc[a][b][m][n] = (f32x4){0.f, 0.f, 0.f, 0.f}; }
        cur = nxt; cA = nA; cB = nB; ++ui;
        if constexpr (ALIGN_EPI) { if (wr == 1) PG8_BAR; }
    }
    PG8_WAIT_V(0);
    if constexpr (!ALIGN_EPI) { if (wr == 0) PG8_BAR; }
    PG8_BAR;
    if constexpr (Epi::AFTER_DRAIN) { E.fused(acc, cur, wr, wc, fr, fq, lds, wid, lane); S.done(cur); }
#undef PG8_SA
#undef PG8_SB
#undef PG8_STAGE
#undef PG8_KT
#undef PG8_NEXT
#undef PG8_LDA
#undef PG8_LDB
#undef PG8_MMA
#undef PG8_WAIT_V
#undef PG8_WAIT_L
#undef PG8_BAR
#undef PG8_SCHED
}
}

#define GAS __attribute__((address_space(1)))
#define LAS __attribute__((address_space(3)))
typedef unsigned short bf16;
typedef unsigned v4u __attribute__((ext_vector_type(4)));
typedef float f32x4 __attribute__((ext_vector_type(4)));
typedef short bf16x8 __attribute__((ext_vector_type(8)));
typedef GAS unsigned gu32;
typedef GAS unsigned long long gu64;
#define RLX_AGENT __ATOMIC_RELAXED, __HIP_MEMORY_SCOPE_AGENT
#define LDS_WAIT() asm volatile("s_waitcnt lgkmcnt(0)" ::: "memory")
#define VM_WAIT() asm volatile("s_waitcnt vmcnt(0)" ::: "memory")
__device__ __forceinline__ unsigned long long rt() { return __builtin_amdgcn_s_memrealtime(); }
__device__ __forceinline__ unsigned f2bf(float f) { unsigned u = __builtin_bit_cast(unsigned, f); return (u + 0x7fffu + ((u >> 16) & 1u)) >> 16; }
__device__ __forceinline__ unsigned pk2(float lo, float hi) { return f2bf(lo) | (f2bf(hi) << 16); }

#define XB_TMO      128
#define XB_XCNT(j)  (256  + 64 * (j))
#define XB_XSUB(j)  (1280 + 64 * (j))
#define XB_XGEN(j)  (2304 + 64 * (j))
#define XB_TOP      3328
#define XB_TOPGEN   3392
#define XCD_BAR_WORDS 3456
#define XB_SPIN_CAP (1u << 18)

__device__ __forceinline__ unsigned xb_ld(unsigned* p)              { return __hip_atomic_load(p, __ATOMIC_RELAXED, __HIP_MEMORY_SCOPE_AGENT); }
__device__ __forceinline__ unsigned xb_add(unsigned* p, unsigned v) { return __hip_atomic_fetch_add(p, v, __ATOMIC_RELAXED, __HIP_MEMORY_SCOPE_AGENT); }
__device__ __forceinline__ unsigned xb_xcc_id() { return (unsigned)__builtin_amdgcn_s_getreg((3 << 11) | 20) & 0xFu; }
#define XB_SPIN(cond, bar) do { unsigned _sp = 0; while (cond) { __builtin_amdgcn_s_sleep(1); \
    if ((++_sp & 255u) == 0u) { if (xb_ld(&(bar)[XB_TMO])) break; if (_sp > XB_SPIN_CAP) { atomicAdd(&(bar)[XB_TMO], 1u); break; } } } } while (0)

struct XcdBarrier {
    unsigned* bar; unsigned x;
    volatile LAS unsigned* st;
};

__device__ __forceinline__ XcdBarrier xcd_barrier_post(unsigned* bar, volatile LAS unsigned* st) {
    XcdBarrier b; b.bar = bar; b.x = xb_xcc_id(); b.st = st;
    if (threadIdx.x == 0) (void)xb_add(&bar[XB_XCNT(b.x)], 1u);
    return b;
}
__device__ __forceinline__ void xcd_barrier_complete(unsigned* bar, unsigned x, unsigned& nloc, unsigned& nx) {
    const unsigned G = gridDim.x * gridDim.y * gridDim.z;
    unsigned sum, cnt, mine, sp = 0u;
    for (;;) {
        sum = 0u; cnt = 0u; mine = 0u;
#pragma unroll
        for (unsigned j = 0; j < 16; ++j) { const unsigned c = xb_ld(&bar[XB_XCNT(j)]); sum += c; cnt += (c > 0u) ? 1u : 0u; mine = (j == x) ? c : mine; }
        if (sum == G) break;
        __builtin_amdgcn_s_sleep(1);
        if ((++sp & 255u) == 0u) { if (xb_ld(&bar[XB_TMO])) break; if (sp > XB_SPIN_CAP) { atomicAdd(&bar[XB_TMO], 1u); break; } }
    }
    nloc = mine > 0u ? mine : 1u; nx = cnt > 0u ? cnt : 1u;
}

__device__ __forceinline__ void xcd_barrier(const XcdBarrier& b) {
    asm volatile("s_waitcnt vmcnt(0)" ::: "memory");
    __syncthreads();
    if (threadIdx.x == 0) {
        unsigned* bar = b.bar;
        __builtin_amdgcn_s_waitcnt(0);
        unsigned nloc = b.st[0], nx = b.st[1];
        if (nloc == 0u) { xcd_barrier_complete(bar, b.x, nloc, nx); b.st[0] = nloc; b.st[1] = nx; }
        const unsigned old = xb_add(&bar[XB_XSUB(b.x)], 1u);
        const unsigned gen = old / nloc;
        if (old + 1u == (gen + 1u) * nloc) {
            __builtin_amdgcn_fence(__ATOMIC_RELEASE, "agent");
            asm volatile("s_waitcnt vmcnt(0)" ::: "memory");
            const unsigned og = xb_add(&bar[XB_TOP], 1u);
            const unsigned tg = og / nx;
            if (og + 1u == (tg + 1u) * nx) xb_add(&bar[XB_TOPGEN], 1u);
            else XB_SPIN(xb_ld(&bar[XB_TOPGEN]) == tg, bar);
            __builtin_amdgcn_fence(__ATOMIC_ACQUIRE, "agent");
            xb_add(&bar[XB_XGEN(b.x)], 1u);
            asm volatile("s_waitcnt vmcnt(0)" ::: "memory");
        } else {
            XB_SPIN(xb_ld(&bar[XB_XGEN(b.x)]) == gen, bar);
            __builtin_amdgcn_fence(__ATOMIC_ACQUIRE, "agent");
            asm volatile("s_waitcnt vmcnt(0)" ::: "memory");
        }
    }
    __syncthreads();
}


constexpr int NWAVES = 8;
constexpr int NTOK = 32768, DM = 1024, SEQ = 2048, INW = 2304, FF = 3584, NE = 8, DEPTH = 4;
constexpr int COL_K = 512, COL_V = 640, COL_CB = 768, COL_CC = 1280, COL_HC = 1792;
constexpr int MOE_TILES_CAP = 2 * NTOK / 256 + NE;
constexpr int MOE_ROWS_CAP = MOE_TILES_CAP * 256;
constexpr float EPS = 1e-5f;
constexpr float LOG2E = 1.4426950408889634f;
constexpr float QSCALE = 0.125f * LOG2E;
constexpr float SA_X = 4.f, SW_UP = 64.f, SA_ACT = 8.f, SW_DN = 128.f, S_YS = 32.f;
#ifndef DENSE_UP_F8
#define DENSE_UP_F8 3
#endif
#ifndef DENSE_DN_F8
#define DENSE_DN_F8 3
#endif
#ifndef IN_F8
#define IN_F8 8
#endif
#define INF8(l) ((IN_F8 >> (l)) & 1)
constexpr float SW_IN = 64.f;
#define UPF8(i) ((DENSE_UP_F8 >> (i)) & 1)
#define DNF8(i) ((DENSE_DN_F8 >> (i)) & 1)
#ifndef MK_PER_PHASE
#define MK_PER_PHASE 0
#endif
#ifndef ATTN_NAIVE
#define ATTN_NAIVE 0
#endif

constexpr size_t MiB = 1u << 20;
constexpr size_t WS_CTL = 0, CTL_ZERO_BYTES = 1 * MiB;
constexpr size_t WS_WIN = 1 * MiB;
constexpr size_t WS_WOUT = 19 * MiB;
constexpr size_t WS_WDUP = 27 * MiB;
constexpr size_t WS_WDDN = 55 * MiB;
constexpr size_t WS_WMUP = 69 * MiB;
constexpr size_t WS_WMDN = 181 * MiB;
constexpr size_t MOE_SET_UP = 56 * MiB, MOE_SET_DN = 28 * MiB;
constexpr int TAILCVT_KIN = 2;
constexpr int TAILCVT_K = 4;
constexpr size_t WS_ROPEC = 237 * MiB;
constexpr size_t WS_XB = 245 * MiB;
constexpr size_t WS_SSQ = 309 * MiB;
constexpr size_t WS_RT = 310 * MiB;
constexpr size_t WS_LIST = 311 * MiB;
constexpr size_t WS_ACT = 312 * MiB;
constexpr size_t WS_PROJ = WS_ACT, WS_Y = WS_ACT + 144 * MiB;
constexpr size_t WS_XS = WS_ACT + 232 * MiB;
constexpr size_t WS_XF8 = WS_ACT + 240 * MiB;
constexpr size_t WS_YS = 774 * MiB;
constexpr size_t WS_END = 906 * MiB;
static_assert(WS_ACT + (size_t)MOE_ROWS_CAP * FF * 2 <= WS_YS && WS_YS + (size_t)MOE_ROWS_CAP * DM * 2 <= WS_END, "ws map");
static_assert((size_t)NTOK * INW * 2 <= 144 * MiB, "proj fits");
static_assert((size_t)MOE_ROWS_CAP * FF <= 232 * MiB && WS_XS + (size_t)NE * NTOK * DM <= WS_END, "xs placement");
constexpr int CW_BAR = 4096;
constexpr int CW_MOECNT = 16384;

constexpr int RING_OFF = 0, RING_BYTES = 131072;
constexpr int LDSCTL_OFF = RING_BYTES, MISC_OFF = LDSCTL_OFF + 320;
constexpr int SSQT_OFF = RING_BYTES + 1024;
constexpr int LDS_BYTES = 147456;
static_assert(SSQT_OFF + 4096 <= LDS_BYTES, "LDS map");

__device__ __forceinline__ float wave_sum(float v) {
#pragma unroll
    for (int o = 1; o < 64; o <<= 1) v += __shfl_xor(v, o);
    return v;
}
__device__ __forceinline__ float wave_max(float v) {
#pragma unroll
    for (int o = 1; o < 64; o <<= 1) v = fmaxf(v, __shfl_xor(v, o));
    return v;
}
typedef unsigned v2u __attribute__((ext_vector_type(2)));
__device__ __forceinline__ float bf2f(unsigned short b) { return __builtin_bit_cast(float, (unsigned)b << 16); }
__device__ __forceinline__ float bflo(unsigned w) { return __builtin_bit_cast(float, w << 16); }
__device__ __forceinline__ float bfhi(unsigned w) { return __builtin_bit_cast(float, w & 0xffff0000u); }

__device__ __forceinline__ void tr_item(const float* W, int ldw, int k0, int n0, bf16* WT, int ldt, int r0, const float* kscale, LAS float* scr, int lane) {
#pragma unroll 8
    for (int i = 0; i < 32; ++i) { const int kk = 2 * i + (lane >> 5); float v = W[(size_t)(k0 + kk) * ldw + n0 + (lane & 31)]; if (kscale) v *= kscale[k0 + kk]; scr[kk * 33 + (lane & 31)] = v; }
    LDS_WAIT(); asm volatile("" ::: "memory");
    const int c = lane & 7;
#pragma unroll
    for (int j = 0; j < 4; ++j) { const int n = (lane >> 3) + 8 * j; const LAS float* s = scr + (8 * c) * 33 + n;
        v4u o; o.x = pk2(s[0 * 33], s[1 * 33]); o.y = pk2(s[2 * 33], s[3 * 33]); o.z = pk2(s[4 * 33], s[5 * 33]); o.w = pk2(s[6 * 33], s[7 * 33]);
        *(GAS v4u*)(WT + (size_t)(r0 + n) * ldt + k0 + 8 * c) = o; }
    LDS_WAIT(); asm volatile("" ::: "memory");
}

template <int MODE> __device__ __forceinline__ void cvt_item(const float* W, int ldw, int k0, int n0, bf16* WT, int ldt, int sel, const float* kscale, int lane) {
    const int n = n0 + 4 * lane; f32x4 v[8];
#pragma unroll
    for (int j = 0; j < 8; ++j) v[j] = *(const GAS f32x4*)(W + (size_t)(k0 + j) * ldw + n);
    if (kscale) {
#pragma unroll
        for (int j = 0; j < 8; ++j) v[j] = v[j] * kscale[k0 + j];
    }
    int r = n;
    if (MODE == 1) { const int pn = n >> 8, loc = n & 255; r = 256 * pn + 128 * ((loc >> 5) & 1) + 32 * (loc >> 6) + (loc & 31); }
    if (MODE == 2) r = 256 * (n >> 7) + 128 * sel + (n & 127);
#pragma unroll
    for (int i = 0; i < 4; ++i) { v4u o; o.x = pk2(v[0][i], v[1][i]); o.y = pk2(v[2][i], v[3][i]); o.z = pk2(v[4][i], v[5][i]); o.w = pk2(v[6][i], v[7][i]);
        *(GAS v4u*)(WT + (size_t)(r + i) * ldt + k0) = o; }
}

template <int MODE> __device__ __forceinline__ void cvt_item_f8(const float* W, int ldw, int k0, int n0, unsigned char* WT, int ldt, int sel, const float* kscale, float sc, int lane) {
    const int n = n0 + 4 * lane; f32x4 v[16];
#pragma unroll
    for (int j = 0; j < 16; ++j) v[j] = *(const GAS f32x4*)(W + (size_t)(k0 + j) * ldw + n);
#pragma unroll
    for (int j = 0; j < 16; ++j) v[j] = v[j] * (kscale ? kscale[k0 + j] * sc : sc);
    int r = n;
    if (MODE == 2) r = 256 * (n >> 7) + 128 * sel + (n & 127);
#pragma unroll
    for (int i = 0; i < 4; ++i) { v4u o; o.x = pg8::pk4_fp8(v[0][i], v[1][i], v[2][i], v[3][i]); o.y = pg8::pk4_fp8(v[4][i], v[5][i], v[6][i], v[7][i]);
        o.z = pg8::pk4_fp8(v[8][i], v[9][i], v[10][i], v[11][i]); o.w = pg8::pk4_fp8(v[12][i], v[13][i], v[14][i], v[15][i]);
        *(GAS v4u*)(WT + (size_t)(r + i) * ldt + k0) = o; }
}

struct Args { const float* in[17]; float* out; unsigned char* ws; int ph_lo, ph_hi; };
#define GIN(a, i) ((const float*)(const GAS float*)(a)->in[i])
#define GOUT(a) ((float*)(GAS float*)(a)->out)
typedef const __attribute__((address_space(4))) Args* KA;
enum { I_X = 0, I_POS, I_ANW, I_WIN, I_SINK, I_CONVW, I_HNW, I_WOUT, I_FNW, I_DG, I_DU, I_DD, I_RW, I_MG, I_MU, I_MD, I_FINW };

struct CvtT { const float* W; const float* ks; unsigned char* WT; int ldw, ldt, k0, n0, mode, sel, f8; float sc; };
__device__ __forceinline__ void cvt_ld(const CvtT& T, f32x4 (&v)[16], float& kv, int lane) {
    const float* p = T.W + (size_t)T.k0 * T.ldw + T.n0 + 4 * lane;
#pragma unroll
    for (int j = 0; j < 16; ++j) v[j] = *(const GAS f32x4*)(p + (size_t)j * T.ldw);
    kv = T.ks ? *(const GAS float*)(T.ks + T.k0 + (lane & 15)) : 1.0f;
}
__device__ __forceinline__ void cvt_st(const CvtT& T, f32x4 (&v)[16], float kv, int lane) {
    const int n = T.n0 + 4 * lane;
    const int kb = __builtin_bit_cast(int, kv * T.sc);
#pragma unroll
    for (int j = 0; j < 16; ++j) v[j] = v[j] * __builtin_bit_cast(float, __builtin_amdgcn_readlane(kb, j));
    int r = n;
    if (T.mode == 1) { const int pn = n >> 8, loc = n & 255; r = 256 * pn + 128 * ((loc >> 5) & 1) + 32 * (loc >> 6) + (loc & 31); }
    if (T.mode == 2) r = 256 * (n >> 7) + 128 * T.sel + (n & 127);
    if (T.f8) {
#pragma unroll
        for (int i = 0; i < 4; ++i) { v4u o; o.x = pg8::pk4_fp8(v[0][i], v[1][i], v[2][i], v[3][i]); o.y = pg8::pk4_fp8(v[4][i], v[5][i], v[6][i], v[7][i]);
            o.z = pg8::pk4_fp8(v[8][i], v[9][i], v[10][i], v[11][i]); o.w = pg8::pk4_fp8(v[12][i], v[13][i], v[14][i], v[15][i]);
            *(GAS v4u*)(T.WT + (size_t)(r + i) * T.ldt + T.k0) = o; }
    } else {
#pragma unroll
        for (int i = 0; i < 4; ++i) { v4u o0, o1; o0.x = pk2(v[0][i], v[1][i]); o0.y = pk2(v[2][i], v[3][i]); o0.z = pk2(v[4][i], v[5][i]); o0.w = pk2(v[6][i], v[7][i]);
            o1.x = pk2(v[8][i], v[9][i]); o1.y = pk2(v[10][i], v[11][i]); o1.z = pk2(v[12][i], v[13][i]); o1.w = pk2(v[14][i], v[15][i]);
            GAS v4u* dp = (GAS v4u*)((bf16*)T.WT + (size_t)(r + i) * T.ldt + T.k0); dp[0] = o0; dp[1] = o1; }
    }
}
template <class G> __device__ __forceinline__ void cvt_pipeline(const G& get, int cu, int NCU, int lane, int tlim = 0x7fffffff) {
    CvtT Ta, Tb; f32x4 va[16], vb[16]; float ka = 1.0f, kb = 1.0f;
    int t = cu; bool ha = t < tlim && get(t, Ta); if (ha) cvt_ld(Ta, va, ka, lane);
    while (ha) {
        t += NCU; const bool hb = t < tlim && get(t, Tb); if (hb) cvt_ld(Tb, vb, kb, lane);
        cvt_st(Ta, va, ka, lane);
        if (!hb) break;
        t += NCU; ha = t < tlim && get(t, Ta); if (ha) cvt_ld(Ta, va, ka, lane);
        cvt_st(Tb, vb, kb, lane);
    }
}
struct MoeCvt { KA a; unsigned char* ws; int i, l, wave;
    __device__ __forceinline__ bool operator()(int t, CvtT& T) const {
        constexpr int T_G = 8 * 14, T_D = 28 * 4, PER_E = 2 * T_G + T_D;
        if (t >= NE * PER_E) return false;
        const int e = t / PER_E; int r = t % PER_E;
        if (r < 2 * T_G) { const int sel = r / T_G, q = r % T_G;
            T = CvtT{GIN(a, sel ? I_MU : I_MG) + (size_t)(i * NE + e) * DM * FF, GIN(a, I_FNW) + l * DM, ws + WS_WMUP + (size_t)i * MOE_SET_UP + (size_t)e * 2 * FF * DM, FF, DM, 16 * ((q / 14) * 8 + wave), 256 * (q % 14), 2, sel, 1, SW_UP}; }
        else { r -= 2 * T_G;
            T = CvtT{GIN(a, I_MD) + (size_t)(i * NE + e) * FF * DM, nullptr, ws + WS_WMDN + (size_t)i * MOE_SET_DN + (size_t)e * DM * FF, DM, FF, 16 * ((r / 4) * 8 + wave), 256 * (r % 4), 0, 0, 1, SW_DN}; }
        return true; } };
struct ProCvt { KA a; unsigned char* ws; int wave;
    __device__ __forceinline__ bool operator()(int t, CvtT& T) const {
        constexpr int T_IN = 8 * 9, T_OUT = 8 * 4, T_G = 8 * 14, T_D = 28 * 4;
        if (t >= 4 * T_IN + 4 * T_OUT + 4 * T_G + 2 * T_D) return false;
        int r = t;
        if (r < 4 * T_IN) { const int l = r / T_IN, q = r % T_IN;
            T = CvtT{GIN(a, I_WIN) + (size_t)l * DM * INW, GIN(a, I_ANW) + l * DM, ws + WS_WIN + (size_t)l * INW * DM * 2, INW, DM, 16 * ((q / 9) * 8 + wave), 256 * (q % 9), 1, 0, INF8(l), INF8(l) ? SW_IN : 1.0f}; return true; }
        r -= 4 * T_IN;
        if (r < 4 * T_OUT) { const int l = r / T_OUT, q = r % T_OUT;
            T = CvtT{GIN(a, I_WOUT) + (size_t)l * DM * DM, nullptr, ws + WS_WOUT + (size_t)l * DM * DM * 2, DM, DM, 16 * ((q / 4) * 8 + wave), 256 * (q % 4), 0, 0, 0, 1.0f}; return true; }
        r -= 4 * T_OUT;
        if (r < 4 * T_G) { const int sel = r / (2 * T_G), rr = r % (2 * T_G), i = rr / T_G, q = rr % T_G; const int f8 = UPF8(i);
            T = CvtT{GIN(a, sel ? I_DU : I_DG) + (size_t)i * DM * FF, GIN(a, I_FNW) + (2 * i) * DM, ws + WS_WDUP + (size_t)i * 2 * FF * DM * 2, FF, DM, 16 * ((q / 14) * 8 + wave), 256 * (q % 14), 2, sel, f8, f8 ? SW_UP : 1.0f}; return true; }
        r -= 4 * T_G;
        { const int i = r / T_D, q = r % T_D; const int f8 = DNF8(i);
            T = CvtT{GIN(a, I_DD) + (size_t)i * FF * DM, nullptr, ws + WS_WDDN + (size_t)i * DM * FF * 2, DM, FF, 16 * ((q / 4) * 8 + wave), 256 * (q % 4), 0, 0, f8, f8 ? SW_DN : 1.0f}; return true; } } };

__device__ const double INVF_REV[32] = {
    0.15915494309189535, 0.11934937021124886, 0.08949940160889101, 0.06711508300522726,
    0.050329212104487035, 0.03774158471741977, 0.0283021958306234, 0.02122365276477766,
    0.015915494309189534, 0.011934937021124886, 0.008949940160889102, 0.006711508300522725,
    0.005032921210448704, 0.003774158471741977, 0.00283021958306234, 0.0021223652764777662,
    0.0015915494309189536, 0.0011934937021124885, 0.0008949940160889102, 0.0006711508300522726,
    0.0005032921210448703, 0.00037741584717419774, 0.00028302195830623395, 0.0002122365276477766,
    0.00015915494309189535, 0.00011934937021124886, 8.949940160889102e-05, 6.711508300522725e-05,
    5.0329212104487035e-05, 3.774158471741978e-05, 2.8302195830623396e-05, 2.122365276477766e-05
};

__device__ __forceinline__ void p_prologue(KA a, unsigned char* ws, LAS unsigned char* lds, int gw, int NGW, int wave, int lane, int gtid, int NGT) {
    { const ProCvt get{a, ws, wave}; cvt_pipeline(get, gw >> 3, NGW >> 3, lane); }
    { const int* pos = (const int*)GIN(a, I_POS); unsigned* rcs = (unsigned*)(ws + WS_ROPEC);
      for (int i = gtid; i < NTOK * 32; i += NGT) { const int t = i >> 5, j = i & 31; double r = (double)pos[t] * INVF_REV[j]; r -= floor(r);
          const float rf = (float)r; const _Float16 ch = (_Float16)__builtin_amdgcn_cosf(rf), sh = (_Float16)__builtin_amdgcn_sinf(rf);
          rcs[i] = (unsigned)__builtin_bit_cast(unsigned short, ch) | ((unsigned)__builtin_bit_cast(unsigned short, sh) << 16); } }
    { const float* x = GIN(a, I_X); bf16* xb = (bf16*)(ws + WS_XB); float* ssq = (float*)(ws + WS_SSQ);
      for (int m0 = gw; m0 < NTOK; m0 += 4 * NGW) {
          f32x4 v[4][4];
#pragma unroll
          for (int b = 0; b < 4; ++b) { const int m = (m0 + b * NGW < NTOK) ? m0 + b * NGW : m0; const GAS f32x4* xr = (const GAS f32x4*)(x + (size_t)m * DM) + lane;
#pragma unroll
              for (int j = 0; j < 4; ++j) v[b][j] = xr[64 * j]; }
#pragma unroll
          for (int b = 0; b < 4; ++b) { const int m = m0 + b * NGW; if (m < NTOK) { float s = 0.f;
#pragma unroll
              for (int j = 0; j < 4; ++j) s += (v[b][j].x * v[b][j].x + v[b][j].y * v[b][j].y) + (v[b][j].z * v[b][j].z + v[b][j].w * v[b][j].w);
              s = wave_sum(s);
              GAS unsigned long long* o8 = (GAS unsigned long long*)(xb + (size_t)m * DM) + lane;
#pragma unroll
              for (int j = 0; j < 4; ++j) o8[64 * j] = (unsigned long long)pk2(v[b][j].x, v[b][j].y) | ((unsigned long long)pk2(v[b][j].z, v[b][j].w) << 32);
              if (lane == 0) *(GAS f32x4*)(ssq + (size_t)m * 4) = (f32x4){s, 0.f, 0.f, 0.f}; } } } }
}

__device__ __forceinline__ void p_moe_weights(KA a, unsigned char* ws, LAS unsigned char* lds, int i, int gw, int NGW, int wave, int lane, int t0 = 0) {
    const MoeCvt get{a, ws, i, 2 * i + 1, wave}; cvt_pipeline(get, t0 + (gw >> 3), NGW >> 3, lane);
}

__device__ __forceinline__ void attn_naive_item(int t, int g, const bf16* P, const float* sinks, const float* hnw, bf16* Y, LAS float* sc, int lane) {
    const int s = t & (SEQ - 1); const int nk = (s + 1 < 128) ? (s + 1) : 128;
    { const uint2 raw = *(const uint2*)(P + (size_t)t * INW + g * 256 + lane * 4);
      sc[lane * 4 + 0] = bflo(raw.x); sc[lane * 4 + 1] = bfhi(raw.x); sc[lane * 4 + 2] = bflo(raw.y); sc[lane * 4 + 3] = bfhi(raw.y); }
    LDS_WAIT(); asm volatile("" ::: "memory");
    float d[2][4];
#pragma unroll
    for (int kk = 0; kk < 2; ++kk) {
        const int kidx = lane + 64 * kk;
#pragma unroll
        for (int h = 0; h < 4; ++h) d[kk][h] = 0.f;
        if (kidx < nk) {
            const bf16* kp = P + (size_t)(t - kidx) * INW + COL_K + g * 64;
#pragma unroll
            for (int c = 0; c < 8; ++c) { const uint4 raw = *(const uint4*)(kp + 8 * c);
                const float kf[8] = {bflo(raw.x), bfhi(raw.x), bflo(raw.y), bfhi(raw.y), bflo(raw.z), bfhi(raw.z), bflo(raw.w), bfhi(raw.w)};
#pragma unroll
                for (int h = 0; h < 4; ++h)
#pragma unroll
                    for (int e = 0; e < 8; ++e) d[kk][h] += kf[e] * sc[h * 64 + 8 * c + e]; }
        } else {
#pragma unroll
            for (int h = 0; h < 4; ++h) d[kk][h] = -INFINITY;
        }
    }
    float inv_l[4];
#pragma unroll
    for (int h = 0; h < 4; ++h) {
        const float sk = sinks[4 * g + h] * LOG2E;
        const float m = fmaxf(wave_max(fmaxf(d[0][h], d[1][h])), sk);
        const float p0 = __builtin_amdgcn_exp2f(d[0][h] - m), p1 = __builtin_amdgcn_exp2f(d[1][h] - m);
        const float l = wave_sum(p0 + p1) + __builtin_amdgcn_exp2f(sk - m);
        sc[256 + h * 128 + lane] = p0; sc[256 + h * 128 + 64 + lane] = p1; inv_l[h] = 1.0f / l;
    }
    LDS_WAIT(); asm volatile("" ::: "memory");
    float o[4] = {0.f, 0.f, 0.f, 0.f};
    const bf16* vp = P + (size_t)t * INW + COL_V + g * 64 + lane;
    for (int key = 0; key < nk; ++key) { const float v = bf2f(vp[-(ptrdiff_t)key * INW]);
#pragma unroll
        for (int h = 0; h < 4; ++h) o[h] += sc[256 + h * 128 + key] * v; }
#pragma unroll
    for (int h = 0; h < 4; ++h) { const float ov = o[h] * inv_l[h]; const float ss = wave_sum(ov * ov); const float r = __builtin_amdgcn_rsqf(ss * (1.0f / 64.0f) + EPS);
        const int col = (4 * g + h) * 64 + lane; Y[(size_t)t * DM + col] = (bf16)f2bf(ov * r * hnw[col]); }
    LDS_WAIT(); asm volatile("" ::: "memory");
}
typedef float f32x16 __attribute__((ext_vector_type(16)));
typedef short s16x4 __attribute__((ext_vector_type(4)));
__device__ __forceinline__ s16x4 vtr(const LAS unsigned char* p) { return __builtin_bit_cast(s16x4, __builtin_amdgcn_ds_read_tr16_b64_v4i16((LAS s16x4*)p)); }
__device__ __forceinline__ unsigned cvtpk(float lo, float hi) { unsigned r; asm volatile("v_cvt_pk_bf16_f32 %0, %1, %2" : "=v"(r) : "v"(lo), "v"(hi)); return r; }
__device__ __forceinline__ void attn_unit(int b, int g, int qb, const bf16* P, const float* sinks, const float* hnw, bf16* Y, LAS unsigned char* lds, int wave, int lane) {
    const int tokb = b * SEQ + qb * 128;
#pragma unroll
    for (int i = 0; i < 8; ++i) {
        const int piece = wave * 8 + i, isV = piece >> 5, pp = piece & 31, slot = pp * 64 + lane, kk = slot >> 3, cs = slot & 7;
        const int c = isV ? (cs ^ (4 * ((kk >> 1) & 1))) : (cs ^ ((kk >> 1) & 7));
        int tok = tokb - 128 + kk; if (qb == 0 && kk < 128) tok += 128;
        const bf16* src = P + (size_t)tok * INW + (isV ? COL_V : COL_K) + g * 64 + 8 * c;
        __builtin_amdgcn_global_load_lds((const unsigned*)src, (LAS unsigned*)(lds + isV * 32768 + pp * 1024), 16, 0, 0);
    }
    const int h = 4 * g + (wave >> 1), hw = wave & 1, r = lane & 31, hh = lane >> 5;
    const float sk = sinks[h] * LOG2E;
    const int kswz = (r >> 1) & 7;
    const int q4 = (lane & 15) >> 2, sw = (q4 >> 1) & 1, xoff = 32 * ((lane >> 4) & 1) + 8 * (lane & 3);
    const int voff0 = 64 * sw + xoff, voff1 = 64 * (1 - sw) + xoff;
    asm volatile("s_waitcnt vmcnt(0)" ::: "memory"); __builtin_amdgcn_s_barrier(); asm volatile("" ::: "memory");
#pragma unroll 1
    for (int sb = 0; sb < 2; ++sb) {
        const int T0 = 2 * hw + sb;
        const int tok = tokb + 32 * T0 + r;
        const bf16* qrow = P + (size_t)tok * INW + h * 64 + 8 * hh;
        bf16x8 qf[4];
#pragma unroll
        for (int ds = 0; ds < 4; ++ds) qf[ds] = *(const bf16x8*)(qrow + 16 * ds);
        f32x16 st[5];
        const LAS unsigned char* kr = lds + (32 * T0 + r) * 128;
#pragma unroll
        for (int ti = 0; ti < 5; ++ti) {
            f32x16 acc = {0.f, 0.f, 0.f, 0.f, 0.f, 0.f, 0.f, 0.f, 0.f, 0.f, 0.f, 0.f, 0.f, 0.f, 0.f, 0.f};
#pragma unroll
            for (int ds = 0; ds < 4; ++ds) { const bf16x8 a = *(const LAS bf16x8*)(kr + ti * 4096 + (((2 * ds + hh) ^ kswz) << 4)); acc = __builtin_amdgcn_mfma_f32_32x32x16_bf16(a, qf[ds], acc, 0, 0, 0); }
            st[ti] = acc;
        }
        float m = -INFINITY;
#pragma unroll
        for (int ti = 0; ti < 5; ++ti)
#pragma unroll
            for (int rg = 0; rg < 16; ++rg) { const int cr = (rg & 3) + 8 * (rg >> 2) + 4 * hh; bool vis = true;
                if (ti == 0) vis = cr > r; if (ti == 4) vis = cr <= r; if (qb == 0 && T0 + ti < 4) vis = false;
                const float sv = vis ? st[ti][rg] : -INFINITY; st[ti][rg] = sv; m = fmaxf(m, sv); }
        m = fmaxf(m, __shfl_xor(m, 32)); m = fmaxf(m, sk);
        float l = 0.f;
#pragma unroll
        for (int ti = 0; ti < 5; ++ti)
#pragma unroll
            for (int rg = 0; rg < 16; ++rg) { const float pv = __builtin_amdgcn_exp2f(st[ti][rg] - m); st[ti][rg] = pv; l += pv; }
        l += __shfl_xor(l, 32); l += __builtin_amdgcn_exp2f(sk - m);
        f32x16 o0 = {0.f, 0.f, 0.f, 0.f, 0.f, 0.f, 0.f, 0.f, 0.f, 0.f, 0.f, 0.f, 0.f, 0.f, 0.f, 0.f}, o1 = o0;
        const LAS unsigned char* vb = lds + 32768 + T0 * 4096 + (4 * hh + q4) * 128;
#pragma unroll
        for (int ti = 0; ti < 5; ++ti)
#pragma unroll
            for (int ks = 0; ks < 2; ++ks) {
                v4u pw; pw.x = cvtpk(st[ti][8 * ks + 0], st[ti][8 * ks + 1]); pw.y = cvtpk(st[ti][8 * ks + 2], st[ti][8 * ks + 3]); pw.z = cvtpk(st[ti][8 * ks + 4], st[ti][8 * ks + 5]); pw.w = cvtpk(st[ti][8 * ks + 6], st[ti][8 * ks + 7]);
                const bf16x8 pf = __builtin_bit_cast(bf16x8, pw);
                const LAS unsigned char* vp = vb + ti * 4096 + ks * 2048;
                { const s16x4 lo = vtr(vp + voff0), hi = vtr(vp + 1024 + voff0); const bf16x8 vf = {lo[0], lo[1], lo[2], lo[3], hi[0], hi[1], hi[2], hi[3]}; o0 = __builtin_amdgcn_mfma_f32_32x32x16_bf16(vf, pf, o0, 0, 0, 0); }
                { const s16x4 lo = vtr(vp + voff1), hi = vtr(vp + 1024 + voff1); const bf16x8 vf = {lo[0], lo[1], lo[2], lo[3], hi[0], hi[1], hi[2], hi[3]}; o1 = __builtin_amdgcn_mfma_f32_32x32x16_bf16(vf, pf, o1, 0, 0, 0); }
            }
        const float il = 1.0f / l; float ss = 0.f;
#pragma unroll
        for (int rg = 0; rg < 16; ++rg) { o0[rg] *= il; o1[rg] *= il; ss += o0[rg] * o0[rg] + o1[rg] * o1[rg]; }
        ss += __shfl_xor(ss, 32);
        const float rn = __builtin_amdgcn_rsqf(ss * (1.0f / 64.0f) + EPS);
        bf16* yrow = Y + (size_t)tok * DM + h * 64 + 4 * hh; const float* wrow = hnw + h * 64 + 4 * hh;
#pragma unroll
        for (int q = 0; q < 4; ++q) {
            const f32x4 w0 = *(const f32x4*)(wrow + 8 * q), w1 = *(const f32x4*)(wrow + 32 + 8 * q);
            v2u a; a.x = cvtpk(o0[4 * q + 0] * rn * w0[0], o0[4 * q + 1] * rn * w0[1]); a.y = cvtpk(o0[4 * q + 2] * rn * w0[2], o0[4 * q + 3] * rn * w0[3]);
            v2u c; c.x = cvtpk(o1[4 * q + 0] * rn * w1[0], o1[4 * q + 1] * rn * w1[1]); c.y = cvtpk(o1[4 * q + 2] * rn * w1[2], o1[4 * q + 3] * rn * w1[3]);
            *(GAS v2u*)(yrow + 8 * q) = a; *(GAS v2u*)(yrow + 32 + 8 * q) = c;
        }
    }
    asm volatile("s_waitcnt lgkmcnt(0)" ::: "memory"); __builtin_amdgcn_s_barrier(); asm volatile("" ::: "memory");
}
__device__ __forceinline__ void load_u8(const bf16* P, int t, int ch, float* u) {
    const uint4 c = *(const uint4*)(P + (size_t)t * INW + COL_CC + ch); const uint4 h = *(const uint4*)(P + (size_t)t * INW + COL_HC + ch);
    u[0] = bflo(c.x) * bflo(h.x); u[1] = bfhi(c.x) * bfhi(h.x); u[2] = bflo(c.y) * bflo(h.y); u[3] = bfhi(c.y) * bfhi(h.y);
    u[4] = bflo(c.z) * bflo(h.z); u[5] = bfhi(c.z) * bfhi(h.z); u[6] = bflo(c.w) * bflo(h.w); u[7] = bfhi(c.w) * bfhi(h.w);
}
__device__ __forceinline__ void conv_item(int t0, const bf16* P, const float* cw  , const float* hnw  , bf16* Y, int lane) {
    const int ch = 8 * lane; float w0[8], w1[8], w2[8], hw[8], u1[8], u2[8];
#pragma unroll
    for (int i = 0; i < 8; ++i) { w0[i] = cw[ch + i]; w1[i] = cw[512 + ch + i]; w2[i] = cw[1024 + ch + i]; hw[i] = hnw[512 + ch + i]; u1[i] = 0.f; u2[i] = 0.f; }
    if ((t0 & (SEQ - 1)) != 0) { load_u8(P, t0 - 1, ch, u1); load_u8(P, t0 - 2, ch, u2); }
    for (int tb = t0; tb < t0 + 16; tb += 4) {
        uint4 cc[4], hh[4], bb[4];
#pragma unroll
        for (int q = 0; q < 4; ++q) { const bf16* row = P + (size_t)(tb + q) * INW + ch; cc[q] = *(const uint4*)(row + COL_CC); hh[q] = *(const uint4*)(row + COL_HC); bb[q] = *(const uint4*)(row + COL_CB); }
#pragma unroll
        for (int q = 0; q < 4; ++q) { const int t = tb + q; const uint4 c = cc[q], h = hh[q], b = bb[q];
            const float u[8] = {bflo(c.x) * bflo(h.x), bfhi(c.x) * bfhi(h.x), bflo(c.y) * bflo(h.y), bfhi(c.y) * bfhi(h.y), bflo(c.z) * bflo(h.z), bfhi(c.z) * bfhi(h.z), bflo(c.w) * bflo(h.w), bfhi(c.w) * bfhi(h.w)};
            const float gb[8] = {bflo(b.x), bfhi(b.x), bflo(b.y), bfhi(b.y), bflo(b.z), bfhi(b.z), bflo(b.w), bfhi(b.w)};
            float o[8]; float ss = 0.f;
#pragma unroll
            for (int i = 0; i < 8; ++i) { o[i] = gb[i] * (w0[i] * u2[i] + w1[i] * u1[i] + w2[i] * u[i]); ss += o[i] * o[i]; }
            ss += __shfl_xor(ss, 1); ss += __shfl_xor(ss, 2); ss += __shfl_xor(ss, 4);
            const float r = __builtin_amdgcn_rsqf(ss * (1.0f / 64.0f) + EPS);
            v4u w; w.x = pk2(o[0] * r * hw[0], o[1] * r * hw[1]); w.y = pk2(o[2] * r * hw[2], o[3] * r * hw[3]); w.z = pk2(o[4] * r * hw[4], o[5] * r * hw[5]); w.w = pk2(o[6] * r * hw[6], o[7] * r * hw[7]);
            *(GAS v4u*)(Y + (size_t)t * DM + 512 + ch) = w;
#pragma unroll
            for (int i = 0; i < 8; ++i) { u2[i] = u1[i]; u1[i] = u[i]; } }
    }
}

struct MoeMeta { int cnt[8]; int rowstart[8]; int tend[8]; int ntiles; };
__device__ __forceinline__ MoeMeta moe_meta(gu32* ctl, int i) {
    MoeMeta m; int acc = 0;
#pragma unroll
    for (int e = 0; e < 8; ++e) { m.cnt[e] = __builtin_amdgcn_readfirstlane((int)__hip_atomic_load(ctl + CW_MOECNT + (i * 8 + e) * 64, RLX_AGENT)); m.rowstart[e] = acc * 256; acc += (m.cnt[e] + 255) >> 8; m.tend[e] = acc; }
    m.ntiles = acc; return m;
}
__device__ __forceinline__ int tailcvt_idle_in(int G) { const int r = ((NTOK / 256) * (INW / 256)) % G; return r != 0 ? G - r : 0; }
__device__ __forceinline__ int tailcvt_idle(gu32* ctl, int G) { const MoeMeta m0 = moe_meta(ctl, 0); const int nu = m0.ntiles * 4, r = nu % G; return (DEPTH >= 4 && r != 0) ? G - r : 0; }
__device__ __forceinline__ void p_router(KA a, unsigned char* ws, LAS unsigned char* lds, gu32* ctl, const bf16* XBm, int l, int i, int ci, int wave, int lane, int tid, int G) {
    LAS int* lcnt = (LAS int*)(lds + SSQT_OFF);
    LAS int* ltok = (LAS int*)(lds + SSQT_OFF + 256);
    LAS unsigned* lrow = (LAS unsigned*)(lds + RING_OFF);
    const int TPB = (NTOK + G - 1) / G, tb = blockIdx.x * TPB, te = (tb + TPB < NTOK) ? tb + TPB : NTOK;
    if (tid < 16) lcnt[tid] = 0;
    __syncthreads();
    int* tok_e = (int*)(ws + WS_RT); float* tok_g = (float*)(ws + WS_RT + 512 * 1024);
    float w[2][8][8];
    { const float* rw = GIN(a, I_RW) + (size_t)i * DM * NE; const float* nw = GIN(a, I_FNW) + l * DM;
#pragma unroll
      for (int j = 0; j < 2; ++j)
#pragma unroll
          for (int c = 0; c < 8; ++c) { const int d = 8 * lane + 512 * j + c; const float n = nw[d]; const f32x4 r0 = *(const f32x4*)(rw + d * 8), r1 = *(const f32x4*)(rw + d * 8 + 4);
              w[j][c][0] = r0.x * n; w[j][c][1] = r0.y * n; w[j][c][2] = r0.z * n; w[j][c][3] = r0.w * n; w[j][c][4] = r1.x * n; w[j][c][5] = r1.y * n; w[j][c][6] = r1.z * n; w[j][c][7] = r1.w * n; } }
    for (int t0 = tb + wave; t0 < te; t0 += 2 * NWAVES) {
        v4u xr2[2][2];
#pragma unroll
        for (int b = 0; b < 2; ++b) { const int t = (t0 + b * NWAVES < te) ? t0 + b * NWAVES : t0; const GAS v4u* xr = (const GAS v4u*)(XBm + (size_t)t * DM) + lane;
#pragma unroll
            for (int j = 0; j < 2; ++j) xr2[b][j] = xr[64 * j]; }
#pragma unroll
        for (int b = 0; b < 2; ++b) { const int t = t0 + b * NWAVES; if (t < te) {
        float s = 0.f; float lg[8] = {0.f, 0.f, 0.f, 0.f, 0.f, 0.f, 0.f, 0.f}; float xv[2][8];
#pragma unroll
        for (int j = 0; j < 2; ++j) { const v4u r = xr2[b][j];
            xv[j][0] = bflo(r.x); xv[j][1] = bfhi(r.x); xv[j][2] = bflo(r.y); xv[j][3] = bfhi(r.y); xv[j][4] = bflo(r.z); xv[j][5] = bfhi(r.z); xv[j][6] = bflo(r.w); xv[j][7] = bfhi(r.w); }
#pragma unroll
        for (int j = 0; j < 2; ++j)
#pragma unroll
            for (int c = 0; c < 8; ++c) { const float v = xv[j][c]; s += v * v;
#pragma unroll
                for (int e = 0; e < 8; ++e) lg[e] += v * w[j][c][e]; }
        s = wave_sum(s); const float rstd = 1.0f / sqrtf(s * (1.0f / DM) + EPS);
#pragma unroll
        for (int e = 0; e < 8; ++e) lg[e] = wave_sum(lg[e]) * rstd;
        { LAS v2u* o8 = (LAS v2u*)(lrow + (t - tb) * 256) + lane; const float rq = rstd * SA_X;
#pragma unroll
          for (int j = 0; j < 2; ++j) { v2u o; o.x = pg8::pk4_fp8(xv[j][0] * rq, xv[j][1] * rq, xv[j][2] * rq, xv[j][3] * rq); o.y = pg8::pk4_fp8(xv[j][4] * rq, xv[j][5] * rq, xv[j][6] * rq, xv[j][7] * rq); o8[64 * j] = o; } }
        int e0 = 0; float l0 = lg[0];
#pragma unroll
        for (int e = 1; e < 8; ++e) if (lg[e] > l0) { l0 = lg[e]; e0 = e; }
        int e1 = -1; float l1 = -INFINITY;
#pragma unroll
        for (int e = 0; e < 8; ++e) if (e != e0 && lg[e] > l1) { l1 = lg[e]; e1 = e; }
        const float ex = __expf(l1 - l0), g0 = 1.0f / (1.0f + ex), g1 = ex * g0;
        if (lane == 0) {
            const int r0 = __hip_atomic_fetch_add(lcnt + e0, 1, __ATOMIC_RELAXED, __HIP_MEMORY_SCOPE_WORKGROUP), r1 = __hip_atomic_fetch_add(lcnt + e1, 1, __ATOMIC_RELAXED, __HIP_MEMORY_SCOPE_WORKGROUP);
            const int tl = t - tb; ltok[tl * 4 + 0] = e0; ltok[tl * 4 + 1] = e1; ltok[tl * 4 + 2] = r0; ltok[tl * 4 + 3] = r1;
            tok_e[t * 2 + 0] = e0; tok_e[t * 2 + 1] = e1; tok_g[t * 2 + 0] = g0; tok_g[t * 2 + 1] = g1;
        }
        } }
    }
    __syncthreads();
    if (tid < 8) lcnt[8 + tid] = (int)__hip_atomic_fetch_add(ctl + CW_MOECNT + (ci * 8 + tid) * 64, (unsigned)lcnt[tid], RLX_AGENT);
    __syncthreads();
    int* tok_pos = (int*)(ws + WS_RT + 256 * 1024);
    for (int tl = tid; tl < te - tb; tl += NWAVES * 64) {
#pragma unroll
        for (int k = 0; k < 2; ++k) { const int e = ltok[tl * 4 + k], pos = lcnt[8 + e] + ltok[tl * 4 + 2 + k]; tok_pos[(tb + tl) * 2 + k] = pos; }
    }
    unsigned char* xs = ws + WS_XS;
    for (int a0 = wave; a0 < 2 * (te - tb); a0 += 8 * NWAVES) {
        v4u d[8]; size_t dst[8];
#pragma unroll
        for (int q = 0; q < 8; ++q) { const int as = a0 + q * NWAVES; const int asc = (as < 2 * (te - tb)) ? as : a0; const int tl = asc >> 1, k = asc & 1;
            const int e = ltok[tl * 4 + k], pos = lcnt[8 + e] + ltok[tl * 4 + 2 + k];
            d[q] = *((const LAS v4u*)(lrow + tl * 256) + lane); dst[q] = ((size_t)e * NTOK + pos) * DM; }
#pragma unroll
        for (int q = 0; q < 8; ++q) { const int as = a0 + q * NWAVES; if (as < 2 * (te - tb)) *((GAS v4u*)(xs + dst[q]) + lane) = d[q]; }
    }
    __syncthreads();
}
__device__ __forceinline__ void fp8x4_to_f32(unsigned w, float* o) {
    typedef float f2 __attribute__((ext_vector_type(2)));
    const f2 a = __builtin_amdgcn_cvt_pk_f32_fp8((int)w, false), b = __builtin_amdgcn_cvt_pk_f32_fp8((int)w, true);
    o[0] = a.x; o[1] = a.y; o[2] = b.x; o[3] = b.y;
}
__device__ __forceinline__ void p_combine(KA a, unsigned char* ws, gu32* ctl, bf16* XBm, float* OUT, float* ssq, int i, bool last, int gw, int NGW, int lane) {
    const MoeMeta mm = moe_meta(ctl, i);
    const int* tok_e = (const int*)(ws + WS_RT); const int* tok_pos = (const int*)(ws + WS_RT + 256 * 1024); const float* tok_g = (const float*)(ws + WS_RT + 512 * 1024);
    const unsigned char* ys = ws + WS_YS; const float* fw = GIN(a, I_FINW);
    constexpr int NB = 2;
    for (int t0 = gw; t0 < NTOK; t0 += NB * NGW) {
        int row[NB][2]; float g[NB][2];
#pragma unroll
        for (int b = 0; b < NB; ++b) { const int t = (t0 + b * NGW < NTOK) ? t0 + b * NGW : t0;
#pragma unroll
            for (int k = 0; k < 2; ++k) { const int e = tok_e[t * 2 + k]; int rs0 = 0;
#pragma unroll
                for (int j = 0; j < 8; ++j) if (j == e) rs0 = mm.rowstart[j];
                row[b][k] = rs0 + tok_pos[t * 2 + k]; g[b][k] = tok_g[t * 2 + k] * (1.0f / S_YS); } }
        v4u x[NB][2], p[NB], q[NB];
#pragma unroll
        for (int b = 0; b < NB; ++b) { const int t = (t0 + b * NGW < NTOK) ? t0 + b * NGW : t0;
            const GAS v4u* xr = (const GAS v4u*)(XBm + (size_t)t * DM) + 2 * lane;
            x[b][0] = xr[0]; x[b][1] = xr[1];
            p[b] = *((const GAS v4u*)(ys + (size_t)row[b][0] * DM) + lane); q[b] = *((const GAS v4u*)(ys + (size_t)row[b][1] * DM) + lane); }
#pragma unroll
        for (int b = 0; b < NB; ++b) { const int t = t0 + b * NGW; if (t < NTOK) {
            float v[16]; float s = 0.f;
#pragma unroll
            for (int c = 0; c < 4; ++c) { float pf[4], qf[4]; fp8x4_to_f32(p[b][c], pf); fp8x4_to_f32(q[b][c], qf);
                const unsigned x0 = x[b][c >> 1][2 * (c & 1)], x1 = x[b][c >> 1][2 * (c & 1) + 1];
                v[4 * c + 0] = bflo(x0) + (g[b][0] * pf[0] + g[b][1] * qf[0]); v[4 * c + 1] = bfhi(x0) + (g[b][0] * pf[1] + g[b][1] * qf[1]);
                v[4 * c + 2] = bflo(x1) + (g[b][0] * pf[2] + g[b][1] * qf[2]); v[4 * c + 3] = bfhi(x1) + (g[b][0] * pf[3] + g[b][1] * qf[3]); }
#pragma unroll
            for (int c = 0; c < 16; ++c) s += v[c] * v[c];
            s = wave_sum(s);
            if (last) {
                const float r = 1.0f / sqrtf(s * (1.0f / DM) + EPS);
                const GAS f32x4* wp = (const GAS f32x4*)(fw + 16 * lane); GAS f32x4* op = (GAS f32x4*)(OUT + (size_t)t * DM + 16 * lane);
#pragma unroll
                for (int c = 0; c < 4; ++c) { const f32x4 w4 = wp[c]; op[c] = (f32x4){v[4 * c] * r * w4.x, v[4 * c + 1] * r * w4.y, v[4 * c + 2] * r * w4.z, v[4 * c + 3] * r * w4.w}; }
            } else {
                GAS v4u* xo = (GAS v4u*)(XBm + (size_t)t * DM) + 2 * lane;
                v4u o0, o1; o0.x = pk2(v[0], v[1]); o0.y = pk2(v[2], v[3]); o0.z = pk2(v[4], v[5]); o0.w = pk2(v[6], v[7]); o1.x = pk2(v[8], v[9]); o1.y = pk2(v[10], v[11]); o1.z = pk2(v[12], v[13]); o1.w = pk2(v[14], v[15]);
                xo[0] = o0; xo[1] = o1;
                if (lane == 0) *(GAS f32x4*)(ssq + (size_t)t * 4) = (f32x4){s, 0.f, 0.f, 0.f};
            } } }
    }
}

#define PHASE_ENV() KA ap = ap0; GAS unsigned char* wsg_ = (GAS unsigned char*)ws0; int l = l0, G = G0, bx = bx0; asm volatile("" : "+s"(ap), "+s"(wsg_), "+s"(l), "+s"(G), "+s"(bx)); unsigned char* ws = (unsigned char*)wsg_; int tid = tid0, wave = wave0, gw = gw0, NGW = NGW0; asm volatile("" : "+v"(tid), "+s"(wave), "+s"(gw), "+s"(NGW)); int lane = tid & 63; (void)tid; (void)lane; (void)wave; (void)gw; (void)NGW; gu32* ctl = (gu32*)(ws + WS_CTL); (void)ctl; (void)l; (void)G; (void)bx
__global__ void __launch_bounds__(NWAVES * 64, 2) fwd_kernel(Args args) {
    extern __shared__ __attribute__((aligned(16))) unsigned char lds_raw[];
    LAS unsigned char* lds = (LAS unsigned char*)lds_raw;
    asm volatile("s_setreg_imm32_b32 hwreg(HW_REG_MODE, 23, 1), 1");
    volatile LAS unsigned* MISC = (volatile LAS unsigned*)(lds + MISC_OFF);
    const int tid0 = threadIdx.x, wave0 = __builtin_amdgcn_readfirstlane(tid0 >> 6);
    const int G0 = gridDim.x; const int bx0 = blockIdx.x;
    const int vcu = (G0 % 8 == 0) ? (bx0 % 8) * (G0 / 8) + bx0 / 8 : bx0;
    const int gw0 = vcu * NWAVES + wave0, NGW0 = G0 * NWAVES;
    const KA ap0 = (KA)__builtin_amdgcn_kernarg_segment_ptr();
    unsigned char* const ws0 = ap0->ws;
    for (int u = tid0; u < (LDS_BYTES - LDSCTL_OFF) / 4; u += NWAVES * 64) ((LAS unsigned*)(lds + LDSCTL_OFF))[u] = 0u;
    __syncthreads();
    const int lo = ap0->ph_lo, hi = ap0->ph_hi;
    XcdBarrier bar; bar.bar = (unsigned*)(ws0 + WS_CTL) + CW_BAR; bar.x = 0; bar.st = nullptr;
    if (hi - lo > 1) bar = xcd_barrier_post((unsigned*)(ws0 + WS_CTL) + CW_BAR, MISC + 8);
#define PH(p) (lo <= (p) && (p) < hi)
#define SEAM(p) do { if ((p) + 1 < hi) { XcdBarrier b_ = bar; asm volatile("" : "+s"(b_.bar), "+s"(b_.x)); xcd_barrier(b_); } } while (0)
    int pid = 0;
    if (PH(pid)) { const int l0 = 0; PHASE_ENV(); p_prologue(ap, ws, lds, gw, NGW, wave, lane, bx * (NWAVES * 64) + tid, G * NWAVES * 64); SEAM(pid); }
    ++pid;
    for (int l0 = 0; l0 < DEPTH; ++l0) {
        if (PH(pid)) { PHASE_ENV();
            pg8::StaticOrder S; S.init(NTOK, INW, G, bx);
            if (IN_F8 != 0 && INF8(l)) {
                pg8::Gemm g{(const bf16*)(ws + WS_XF8), (const bf16*)(ws + WS_WIN + (size_t)l * INW * DM * 2), NTOK, INW, DM, 0};
                pg8::EpiIn E{(bf16*)(ws + WS_PROJ), (const float*)(ws + WS_SSQ), (const unsigned*)(ws + WS_ROPEC), QSCALE, 1.0f / (SA_X * SW_IN)};
                pg8::gemm_phase<pg8::EpiIn, pg8::StaticOrder, true, true, true>(lds + RING_OFF, g, S, E);
            } else {
                pg8::Gemm g{(const bf16*)(ws + WS_XB), (const bf16*)(ws + WS_WIN) + (size_t)l * INW * DM, NTOK, INW, DM, 0};
                pg8::EpiIn E{(bf16*)(ws + WS_PROJ), (const float*)(ws + WS_SSQ), (const unsigned*)(ws + WS_ROPEC), QSCALE, 1.0f};
                pg8::gemm_phase<pg8::EpiIn, pg8::StaticOrder, true, true>(lds + RING_OFF, g, S, E);
            }
            { const int NIi = tailcvt_idle_in(G), nbusy = G - NIi;
              if (NIi > 0 && bx >= nbusy) { const int it = l >> 1, base = (it == 0 ? 0 : TAILCVT_K * tailcvt_idle(ctl, G)) + (l & 1) * TAILCVT_KIN * NIi;
                  const MoeCvt get{ap, ws, it, 2 * it + 1, wave}; cvt_pipeline(get, base + (bx - nbusy), NIi, lane, base + TAILCVT_KIN * NIi); } }
            SEAM(pid);
        }
        ++pid;
        if (PH(pid)) { PHASE_ENV();
            const float* sinks = GIN(ap, I_SINK) + l * 8; const float* hnw = GIN(ap, I_HNW) + l * DM; const float* cw = GIN(ap, I_CONVW) + l * 3 * 512;
            const bf16* PROJ = (const bf16*)(ws + WS_PROJ); bf16* Y = (bf16*)(ws + WS_Y);
            LAS float* sc = (LAS float*)(lds + RING_OFF + wave * 4096);
#if ATTN_NAIVE
            for (int it = gw; it < NTOK * 2; it += NGW) attn_naive_item(it >> 1, it & 1, PROJ, sinks, hnw, Y, sc, lane);
#else
            (void)sc;
            for (int u = gw >> 3; u < 512; u += G) attn_unit(u >> 5, (u >> 4) & 1, u & 15, PROJ, sinks, hnw, Y, lds + RING_OFF, wave, lane);
#endif
            for (int it = gw; it < NTOK / 16; it += NGW) conv_item(it * 16, PROJ, cw, hnw, Y, lane);
            SEAM(pid);
        }
        ++pid;
        if (PH(pid)) { PHASE_ENV();
            pg8::Gemm g{(const bf16*)(ws + WS_Y), (const bf16*)(ws + WS_WOUT) + (size_t)l * DM * DM, NTOK, DM, DM, 0};
            pg8::StaticOrder S; S.init(NTOK, DM, G, bx);
            const bool dense = (l & 1) == 0, f8 = UPF8(l >> 1) != 0;
            pg8::EpiRes E{(bf16*)(ws + WS_XB), (dense && f8) ? ws + WS_XF8 : nullptr, (float*)(ws + WS_SSQ), (PG8_LAS float*)(lds + SSQT_OFF), 1.0f, SA_X};
            pg8::gemm_phase<pg8::EpiRes, pg8::StaticOrder, true, true>(lds + RING_OFF, g, S, E);
            SEAM(pid);
        }
        ++pid;
        if ((l0 & 1) == 0) {
            if (PH(pid)) { PHASE_ENV(); const int i = l >> 1;
                pg8::StaticOrder S; S.init(NTOK, 2 * FF, G, bx);
                const bool upf8 = UPF8(i) != 0, dnf8 = DNF8(i) != 0;
#define DENSE_UP_SITE(F8G, F8O) do { \
                    pg8::Gemm g{(F8G) ? (const bf16*)(ws + WS_XF8) : (const bf16*)(ws + WS_XB), (F8G) ? (const bf16*)(ws + WS_WDUP + (size_t)i * 2 * FF * DM * 2) : (const bf16*)(ws + WS_WDUP) + (size_t)i * 2 * FF * DM, NTOK, 2 * FF, DM, 0}; \
                    pg8::EpiUp<F8O> E{ws + WS_ACT, FF, (const float*)(ws + WS_SSQ), (F8G) ? 1.0f / (SA_X * SW_UP) : 1.0f, SA_ACT}; \
                    pg8::gemm_phase<pg8::EpiUp<F8O>, pg8::StaticOrder, true, true, F8G>(lds + RING_OFF, g, S, E); } while (0)
                if ((DENSE_UP_F8 & DENSE_DN_F8) != 0 && upf8 && dnf8) DENSE_UP_SITE(true, true);
                if ((DENSE_UP_F8 & ~DENSE_DN_F8 & 3) != 0 && upf8 && !dnf8) DENSE_UP_SITE(true, false);
                if ((~DENSE_UP_F8 & DENSE_DN_F8 & 3) != 0 && !upf8 && dnf8) DENSE_UP_SITE(false, true);
                if ((~DENSE_UP_F8 & ~DENSE_DN_F8 & 3) != 0 && !upf8 && !dnf8) DENSE_UP_SITE(false, false);
#undef DENSE_UP_SITE
                SEAM(pid);
            }
            ++pid;
            if (PH(pid)) { PHASE_ENV(); const int i = l >> 1;
                pg8::StaticOrder S; S.init(NTOK, DM, G, bx);
                if (DENSE_DN_F8 != 0 && (DENSE_DN_F8 == 3 || DNF8(i))) {
                    pg8::Gemm g{(const bf16*)(ws + WS_ACT), (const bf16*)(ws + WS_WDDN + (size_t)i * DM * FF * 2), NTOK, DM, FF, 0};
                    pg8::EpiRes E{(bf16*)(ws + WS_XB), INF8(l + 1) ? ws + WS_XF8 : nullptr, (float*)(ws + WS_SSQ), (PG8_LAS float*)(lds + SSQT_OFF), 1.0f / (SA_ACT * SW_DN), SA_X};
                    pg8::gemm_phase<pg8::EpiRes, pg8::StaticOrder, true, true, true>(lds + RING_OFF, g, S, E);
                } else if (DENSE_DN_F8 != 3) {
                    pg8::Gemm g{(const bf16*)(ws + WS_ACT), (const bf16*)(ws + WS_WDDN) + (size_t)i * DM * FF, NTOK, DM, FF, 0};
                    pg8::EpiRes E{(bf16*)(ws + WS_XB), nullptr, (float*)(ws + WS_SSQ), (PG8_LAS float*)(lds + SSQT_OFF), 1.0f, 0.f};
                    pg8::gemm_phase<pg8::EpiRes, pg8::StaticOrder, true, true, false>(lds + RING_OFF, g, S, E);
                }
                SEAM(pid);
            }
            ++pid;
        } else {
            if (PH(pid)) { PHASE_ENV(); const int i = l >> 1;
                p_router(ap, ws, lds, ctl, (const bf16*)(ws + WS_XB), l, i, i, wave, lane, tid, G);
                p_moe_weights(ap, ws, lds, i, gw, NGW, wave, lane, (i == 1 ? TAILCVT_K * tailcvt_idle(ctl, G) : 0) + 2 * TAILCVT_KIN * tailcvt_idle_in(G));
                SEAM(pid);
            }
            ++pid;
            if (PH(pid)) { PHASE_ENV(); const int i = l >> 1;
                const MoeMeta mm = moe_meta(ctl, i);
                pg8::Gemm g{(const bf16*)(ws + WS_XS), (const bf16*)(ws + WS_WMUP + (size_t)i * MOE_SET_UP), mm.ntiles * 256, 2 * FF, DM, (size_t)2 * FF * DM};
                pg8::MoeOrder S; S.init(mm.ntiles * 256, 2 * FF, G, bx); S.acap = NTOK / 256;
#pragma unroll
                for (int e = 0; e < 8; ++e) S.tend[e] = mm.tend[e];
                pg8::EpiUp<true> E{ws + WS_ACT, FF, nullptr, 1.0f / (SA_X * SW_UP), SA_ACT};
                pg8::gemm_phase<pg8::EpiUp<true>, pg8::MoeOrder, true, true, true>(lds + RING_OFF, g, S, E);
                SEAM(pid);
            }
            ++pid;
            if (PH(pid)) { PHASE_ENV(); const int i = l >> 1;
                const MoeMeta mm = moe_meta(ctl, i);
                pg8::Gemm g{(const bf16*)(ws + WS_ACT), (const bf16*)(ws + WS_WMDN + (size_t)i * MOE_SET_DN), mm.ntiles * 256, DM, FF, (size_t)DM * FF};
                pg8::MoeOrder S; S.init(mm.ntiles * 256, DM, G, bx); S.acap = 0;
#pragma unroll
                for (int e = 0; e < 8; ++e) S.tend[e] = mm.tend[e];
                pg8::EpiYs E{ws + WS_YS, DM, S_YS / (SA_ACT * SW_DN)};
                pg8::gemm_phase<pg8::EpiYs, pg8::MoeOrder, true, true, true>(lds + RING_OFF, g, S, E);
                if (i == 0) { const int NI = tailcvt_idle(ctl, G), nbusy = G - NI;
                    if (NI > 0 && bx >= nbusy) { const MoeCvt get{ap, ws, 1, 3, wave}; cvt_pipeline(get, bx - nbusy, NI, lane, TAILCVT_K * NI); } }
                SEAM(pid);
            }
            ++pid;
            if (PH(pid)) { PHASE_ENV(); const int i = l >> 1; p_combine(ap, ws, ctl, (bf16*)(ws + WS_XB), GOUT(ap), (float*)(ws + WS_SSQ), i, l == DEPTH - 1, gw, NGW, lane); SEAM(pid); }
            ++pid;
        }
    }
#undef PH
#undef SEAM
}
constexpr int N_PHASES = 1 + 2 * (3 + 2) + 2 * (3 + 4);

extern "C" void kernel_launch(void* const* d_in, const int* in_sizes, int n_in, void* d_out, int out_size, void* d_ws, size_t ws_size, hipStream_t stream) {
    static int grid = 0;
    if (grid == 0) {
        if (n_in != 17 || out_size != NTOK * DM || ws_size < WS_END) { fprintf(stderr, "kernel_launch: unexpected shapes (n_in %d, out %d, ws %zu < %zu); nothing launched\n", n_in, out_size, ws_size, (size_t)WS_END); grid = -1; return; }
        int dev = 0, cus = 0, per_cu = 0;
        if (hipGetDevice(&dev) != hipSuccess || hipDeviceGetAttribute(&cus, hipDeviceAttributeMultiprocessorCount, dev) != hipSuccess) { grid = -1; return; }
        if (hipFuncSetAttribute((const void*)fwd_kernel, hipFuncAttributeMaxDynamicSharedMemorySize, LDS_BYTES) != hipSuccess) { fprintf(stderr, "kernel_launch: hipFuncSetAttribute failed\n"); grid = -1; return; }
        if (hipOccupancyMaxActiveBlocksPerMultiprocessor(&per_cu, (const void*)fwd_kernel, NWAVES * 64, LDS_BYTES) != hipSuccess || per_cu < 1) fprintf(stderr, "kernel_launch: occupancy query reports %d blocks per CU\n", per_cu);
        (void)hipGetLastError();
        if ((NTOK + cus - 1) / cus > 128) { fprintf(stderr, "kernel_launch: the router phase keeps 128 token rows per workgroup in LDS: needs >= 256 CUs (got %d); nothing launched\n", cus); grid = -1; return; }
        grid = cus;
    }
    if (grid < 0) return;
    if (hipMemsetAsync((char*)d_ws + WS_CTL, 0, CTL_ZERO_BYTES, stream) != hipSuccess) return;
    Args a{};
    for (int i = 0; i < 17; ++i) a.in[i] = (const float*)d_in[i];
    a.out = (float*)d_out; a.ws = (unsigned char*)d_ws;
#if MK_PER_PHASE
    for (int p = 0; p < N_PHASES; ++p) { a.ph_lo = p; a.ph_hi = p + 1; hipLaunchKernelGGL(fwd_kernel, dim3(grid), dim3(NWAVES * 64), LDS_BYTES, stream, a); }
#else
    a.ph_lo = 0; a.ph_hi = N_PHASES;
    hipLaunchKernelGGL(fwd_kernel, dim3(grid), dim3(NWAVES * 64), LDS_BYTES, stream, a);
#endif
}
```

```cpp
#include <hip/hip_runtime.h>
#include <cstdio>
#include <cstdint>
#include <cstddef>
namespace pg8 {
#define PG8_LAS __attribute__((address_space(3)))
typedef unsigned short bf16_t;
typedef short bf16x8 __attribute__((ext_vector_type(8)));
typedef float f32x4 __attribute__((ext_vector_type(4)));
typedef unsigned u32x4 __attribute__((ext_vector_type(4)));
constexpr int BM = 256, BK = 64, HALF = 128, HTB = HALF * BK * 2  , STAGE_BYTES = 8 * HTB, NXCD = 8, WGM = 8;

__host__ __device__ __forceinline__ int lds_byte(int r, int c) { const int st = (r >> 4) * 2 + (c >> 5), rr = r & 15, cc = c & 31, ob = rr * 64 + cc * 2; return st * 1024 + (ob ^ (((ob >> 9) & 1) << 5)); }
__host__ __device__ __forceinline__ void stage_rc(int b, int& R, int& C) { const int st = b / 1024, sb = b % 1024, swz = sb ^ (((sb >> 9) & 1) << 5); R = (st >> 1) * 16 + swz / 64; C = (st & 1) * 32 + (swz % 64) / 2; }
__host__ __device__ __forceinline__ int perm32(int rho) { const int n = rho >> 4, i = rho & 15; return 8 * (i >> 2) + 4 * n + (i & 3); }

struct Unit { int pm, pn, pe, pa; };
struct Gemm { const bf16_t* A; const bf16_t* Bt; int M, N, K; size_t estep; };

struct StaticOrder {
    int nM, nN, nwg, G, c;
    __host__ __device__ void init(int M, int N, int G_, int c_) { nM = M / BM; nN = N / BM; nwg = nM * nN; G = G_; c = c_; }
    __host__ __device__ bool next(int i, Unit& u) const {
        const long L = (long)i * G + c; if (L >= nwg) return false;
        int wgid = (int)L; { const int q = nwg / NXCD, r = nwg % NXCD, xcd = wgid % NXCD, off = wgid / NXCD; wgid = (xcd < r ? xcd * (q + 1) : r * (q + 1) + (xcd - r) * q) + off; }
        const int nig = WGM * nN, gid = wgid / nig, fm = gid * WGM, gsz = (nM - fm) < WGM ? (nM - fm) : WGM;
        u.pm = fm + ((wgid % nig) % gsz); u.pn = (wgid % nig) / gsz; u.pe = 0; u.pa = u.pm; return true;
    }
    __device__ __forceinline__ void a_ready(const Unit&) const {}
    __device__ __forceinline__ void done(const Unit&) const {}
};

__device__ __forceinline__ unsigned cvt_pk_bf16(float lo, float hi) { unsigned r; asm volatile("v_cvt_pk_bf16_f32 %0, %1, %2" : "=v"(r) : "v"(lo), "v"(hi)); return r; }
typedef float f32x2 __attribute__((ext_vector_type(2)));

typedef unsigned u32x2 __attribute__((ext_vector_type(2)));
constexpr float NORM_EPS = 1e-5f;
__device__ __forceinline__ float row_rstd(const float* ssq, int row) {
    const f32x4 s = *(const f32x4*)(ssq + (size_t)row * 4);
    return __builtin_amdgcn_rsqf(((s[0] + s[1]) + (s[2] + s[3])) * (1.0f / 1024.0f) + NORM_EPS);
}
__device__ __forceinline__ float silu_mul(float g, float u) {
    const float e = __builtin_amdgcn_exp2f(-1.4426950408889634f * g);
    return g * u * __builtin_amdgcn_rcpf(1.0f + e);
}
__device__ __forceinline__ float h_lo(unsigned w) { return (float)__builtin_bit_cast(_Float16, (unsigned short)(w & 0xffffu)); }
__device__ __forceinline__ float h_hi(unsigned w) { return (float)__builtin_bit_cast(_Float16, (unsigned short)(w >> 16)); }
struct EpiIn {
    static constexpr bool PERM = true, AFTER_DRAIN = false, FKOK = false; static constexpr int NST = 0;
    bf16_t* P; const float* ssq; const unsigned* rcs; float qscale, ascale;
    __device__ __forceinline__ void operator()(const f32x4 (&acc)[2][2][4][2], const Unit& u, int wr, int wc, int fr, int fq) const {
        const int row0 = u.pm * BM + wr * 64 + fr;
        const int colb = u.pn * BM + wc * 64 + 8 * fq;
        const bool rope = (u.pn < 2) || (u.pn == 2 && wc < 2);
        const float sc = (u.pn < 2) ? qscale : 1.0f;
        u32x4 cs[4][2], wo[4], vo[4]; f32x4 sv[4];
#pragma unroll
        for (int ai = 0; ai < 2; ++ai) {
#pragma unroll
            for (int m = 0; m < 4; ++m) sv[m] = *(const f32x4*)(ssq + (size_t)(row0 + ai * HALF + m * 16) * 4);
            if (rope) {
#pragma unroll
                for (int m = 0; m < 4; ++m) { const unsigned* cp = rcs + (size_t)(row0 + ai * HALF + m * 16) * 32 + 8 * fq; cs[m][0] = *(const u32x4*)cp; cs[m][1] = *(const u32x4*)(cp + 4); }
            }
            if (ai == 1) {
#pragma unroll
                for (int m = 0; m < 4; ++m) { bf16_t* rp = P + (size_t)(row0 + m * 16) * 2304 + colb; *(u32x4*)rp = wo[m]; *(u32x4*)(rp + 32) = vo[m]; }
            }
#pragma unroll
            for (int m = 0; m < 4; ++m) {
                const float rs = __builtin_amdgcn_rsqf(((sv[m][0] + sv[m][1]) + (sv[m][2] + sv[m][3])) * (1.0f / 1024.0f) + NORM_EPS) * ascale;
                f32x4 a0 = acc[ai][0][m][0] * rs, a1 = acc[ai][0][m][1] * rs, b0 = acc[ai][1][m][0] * rs, b1 = acc[ai][1][m][1] * rs;
                if (rope) {
                    const u32x4 q0 = cs[m][0], q1 = cs[m][1];
                    const f32x4 c0 = {h_lo(q0.x), h_lo(q0.y), h_lo(q0.z), h_lo(q0.w)}, s0 = {h_hi(q0.x), h_hi(q0.y), h_hi(q0.z), h_hi(q0.w)};
                    const f32x4 c1 = {h_lo(q1.x), h_lo(q1.y), h_lo(q1.z), h_lo(q1.w)}, s1 = {h_hi(q1.x), h_hi(q1.y), h_hi(q1.z), h_hi(q1.w)};
                    const f32x4 o0 = (a0 * c0 - b0 * s0) * sc, o1 = (a1 * c1 - b1 * s1) * sc, p0 = (b0 * c0 + a0 * s0) * sc, p1 = (b1 * c1 + a1 * s1) * sc;
                    a0 = o0; a1 = o1; b0 = p0; b1 = p1;
                }
                u32x4 w; w.x = cvt_pk_bf16(a0[0], a0[1]); w.y = cvt_pk_bf16(a0[2], a0[3]); w.z = cvt_pk_bf16(a1[0], a1[1]); w.w = cvt_pk_bf16(a1[2], a1[3]);
                u32x4 v; v.x = cvt_pk_bf16(b0[0], b0[1]); v.y = cvt_pk_bf16(b0[2], b0[3]); v.z = cvt_pk_bf16(b1[0], b1[1]); v.w = cvt_pk_bf16(b1[2], b1[3]);
                wo[m] = w; vo[m] = v;
            }
        }
#pragma unroll
        for (int m = 0; m < 4; ++m) { bf16_t* rp = P + (size_t)(row0 + HALF + m * 16) * 2304 + colb; *(u32x4*)rp = wo[m]; *(u32x4*)(rp + 32) = vo[m]; }
    }
};
__device__ __forceinline__ unsigned pk4_fp8(float a, float b, float c, float d) {
    unsigned w; asm("v_cvt_pk_fp8_f32 %0, %1, %2" : "=v"(w) : "v"(a), "v"(b)); asm("v_cvt_pk_fp8_f32 %0, %1, %2 op_sel:[0,0,1]" : "+v"(w) : "v"(c), "v"(d)); return w;
}
__device__ __forceinline__ float bf_lo(unsigned w) { return __builtin_bit_cast(float, w << 16); }
__device__ __forceinline__ float bf_hi(unsigned w) { return __builtin_bit_cast(float, w & 0xffff0000u); }
struct EpiRes {
    static constexpr bool PERM = true, AFTER_DRAIN = false, FKOK = true; static constexpr int NST = 0;
    bf16_t* XB; unsigned char* XF; float* ssq; PG8_LAS float* tbl; float cs, fs;
    __device__ __forceinline__ void operator()(const f32x4 (&acc)[2][2][4][2], const Unit& u, int wr, int wc, int fr, int fq) const {
        const int col0 = u.pn * BM + wc * 32 + 8 * fq;
        u32x4 rin[2][4][2];
#pragma unroll
        for (int ai = 0; ai < 2; ++ai)
#pragma unroll
            for (int m = 0; m < 4; ++m)
#pragma unroll
                for (int bj = 0; bj < 2; ++bj) rin[ai][m][bj] = *(const u32x4*)(XB + (size_t)(u.pm * BM + ai * HALF + wr * 64 + m * 16 + fr) * 1024 + col0 + bj * HALF);
#pragma unroll
        for (int ai = 0; ai < 2; ++ai)
#pragma unroll
            for (int m = 0; m < 4; ++m) {
                const int rowl = ai * HALF + wr * 64 + m * 16 + fr; const size_t off = (size_t)(u.pm * BM + rowl) * 1024 + col0; float sq = 0.f;
#pragma unroll
                for (int bj = 0; bj < 2; ++bj) {
                    const size_t o = off + bj * HALF;
                    const u32x4 rw = rin[ai][m][bj];
                    const f32x4 r0 = {bf_lo(rw.x), bf_hi(rw.x), bf_lo(rw.y), bf_hi(rw.y)}, r1 = {bf_lo(rw.z), bf_hi(rw.z), bf_lo(rw.w), bf_hi(rw.w)};
                    const f32x4 x0 = r0 + acc[ai][bj][m][0] * cs, x1 = r1 + acc[ai][bj][m][1] * cs;
                    { u32x4 w; w.x = cvt_pk_bf16(x0[0], x0[1]); w.y = cvt_pk_bf16(x0[2], x0[3]); w.z = cvt_pk_bf16(x1[0], x1[1]); w.w = cvt_pk_bf16(x1[2], x1[3]); *(u32x4*)(XB + o) = w; }
                    if (XF) { u32x2 w; w.x = pk4_fp8(x0[0] * fs, x0[1] * fs, x0[2] * fs, x0[3] * fs); w.y = pk4_fp8(x1[0] * fs, x1[1] * fs, x1[2] * fs, x1[3] * fs); *(u32x2*)(XF + o) = w; }
                    sq += ((x0[0] * x0[0] + x0[1] * x0[1]) + (x0[2] * x0[2] + x0[3] * x0[3])) + ((x1[0] * x1[0] + x1[1] * x1[1]) + (x1[2] * x1[2] + x1[3] * x1[3]));
                }
                sq += __shfl_xor(sq, 16); sq += __shfl_xor(sq, 32);
                if (fq == 0) tbl[rowl * 4 + wc] = sq;
            }
        asm volatile("s_waitcnt lgkmcnt(0)" ::: "memory"); __builtin_amdgcn_s_barrier(); asm volatile("" ::: "memory");
        const int lane = fq * 16 + fr;
        if (lane < 32) {
            const int rowl = (wc >> 1) * HALF + wr * 64 + (wc & 1) * 32 + lane;
            const f32x4 t = *(const PG8_LAS f32x4*)(tbl + rowl * 4);
            ssq[(size_t)(u.pm * BM + rowl) * 4 + u.pn] = (t[0] + t[1]) + (t[2] + t[3]);
        }
    }
};
template <bool F8OUT> struct EpiUp {
    static constexpr bool PERM = true, AFTER_DRAIN = false, FKOK = true; static constexpr int NST = 8;
    void* O; int ldc; const float* ssq; float cs, fs;
    static __device__ __forceinline__ float sm(float ag, float au, float k1, float ik2) { return (ag * au) * __builtin_amdgcn_rcpf(__builtin_fmaf(__builtin_amdgcn_exp2f(ag * k1), ik2, ik2)); }
    typedef float v2f __attribute__((ext_vector_type(2)));
    static __device__ __forceinline__ v2f sm2(v2f ag, v2f au, float k1, float ik2) {
        const v2f K1 = {k1, k1}, K2 = {ik2, ik2}; const v2f t = ag * K1; v2f e; e.x = __builtin_amdgcn_exp2f(t.x); e.y = __builtin_amdgcn_exp2f(t.y);
        const v2f d = __builtin_elementwise_fma(e, K2, K2); v2f r; r.x = __builtin_amdgcn_rcpf(d.x); r.y = __builtin_amdgcn_rcpf(d.y); return (ag * au) * r; }
    static __device__ __forceinline__ v2f lo2(f32x4 v) { return __builtin_shufflevector(v, v, 0, 1); }
    static __device__ __forceinline__ v2f hi2(f32x4 v) { return __builtin_shufflevector(v, v, 2, 3); }
    __device__ __forceinline__ void operator()(const f32x4 (&acc)[2][2][4][2], const Unit& u, int wr, int wc, int fr, int fq) const {
        const int row0 = u.pm * BM + wr * 64 + fr, col0 = u.pn * HALF + wc * 32 + 8 * fq;
        float rsv[2][4];
#pragma unroll
        for (int ai = 0; ai < 2; ++ai)
#pragma unroll
            for (int m = 0; m < 4; ++m) rsv[ai][m] = ssq ? row_rstd(ssq, row0 + ai * HALF + m * 16) : 1.0f;
#pragma unroll
        for (int ai = 0; ai < 2; ++ai)
#pragma unroll
            for (int m = 0; m < 4; ++m) {
                const int row = row0 + ai * HALF + m * 16;
                const float rs = rsv[ai][m] * cs, k1 = -1.4426950408889634f * rs, k2 = __builtin_amdgcn_rcpf(rs * rs * (F8OUT ? fs : 1.0f));
                const f32x4 g0 = acc[ai][0][m][0], g1 = acc[ai][0][m][1], u0 = acc[ai][1][m][0], u1 = acc[ai][1][m][1];
                if (F8OUT) {
                    const v2f a0 = sm2(lo2(g0), lo2(u0), k1, k2), a1 = sm2(hi2(g0), hi2(u0), k1, k2), a2 = sm2(lo2(g1), lo2(u1), k1, k2), a3 = sm2(hi2(g1), hi2(u1), k1, k2);
                    u32x2 w; w.x = pk4_fp8(a0.x, a0.y, a1.x, a1.y); w.y = pk4_fp8(a2.x, a2.y, a3.x, a3.y);
                    *(u32x2*)((unsigned char*)O + (size_t)row * ldc + col0) = w;
                } else {
                    u32x4 w;
                    const v2f a0 = sm2(lo2(g0), lo2(u0), k1, k2), a1 = sm2(hi2(g0), hi2(u0), k1, k2), a2 = sm2(lo2(g1), lo2(u1), k1, k2), a3 = sm2(hi2(g1), hi2(u1), k1, k2);
                    w.x = cvt_pk_bf16(a0.x, a0.y); w.y = cvt_pk_bf16(a1.x, a1.y); w.z = cvt_pk_bf16(a2.x, a2.y); w.w = cvt_pk_bf16(a3.x, a3.y);
                    *(u32x4*)((bf16_t*)O + (size_t)row * ldc + col0) = w;
                }
            }
    }
};
struct EpiYs {
    static constexpr bool PERM = true, AFTER_DRAIN = false, FKOK = true; static constexpr int NST = 16;
    unsigned char* O; int ldc; float cs;
    __device__ __forceinline__ void operator()(const f32x4 (&acc)[2][2][4][2], const Unit& u, int wr, int wc, int fr, int fq) const {
        const int row0 = u.pm * BM + wr * 64 + fr, col0 = u.pn * BM + wc * 32 + 8 * fq;
#pragma unroll
        for (int ai = 0; ai < 2; ++ai)
#pragma unroll
            for (int m = 0; m < 4; ++m) { unsigned char* rowp = O + (size_t)(row0 + ai * HALF + m * 16) * ldc + col0;
#pragma unroll
                for (int bj = 0; bj < 2; ++bj) { const f32x4 v0 = acc[ai][bj][m][0] * cs, v1 = acc[ai][bj][m][1] * cs;
                    u32x2 w; w.x = pk4_fp8(v0[0], v0[1], v0[2], v0[3]); w.y = pk4_fp8(v1[0], v1[1], v1[2], v1[3]);
                    *(u32x2*)(rowp + bj * HALF) = w; } }
    }
};
struct MoeOrder : StaticOrder {
    int tend[8]; int acap;
    __device__ __forceinline__ bool next(int i, Unit& u) const {
        if (!StaticOrder::next(i, u)) return false;
        int e = 0, ts = 0;
#pragma unroll
        for (int j = 0; j < 7; ++j) { const bool ge = u.pm >= tend[j]; e += ge ? 1 : 0; ts = ge ? tend[j] : ts; }
        u.pe = __builtin_amdgcn_readfirstlane(e); u.pm = __builtin_amdgcn_readfirstlane(u.pm); u.pn = __builtin_amdgcn_readfirstlane(u.pn);
        u.pa = acap ? __builtin_amdgcn_readfirstlane(e * acap + (u.pm - ts)) : u.pm; return true;
    }
};

__device__ __forceinline__ void pg8_glds(const char* sbase, unsigned voff, unsigned lds_dst) {
    unsigned keep; asm volatile("s_mov_b32 %0, m0\n\ts_mov_b32 m0, %3\n\ts_nop 2\n\tglobal_load_lds_dwordx4 %1, %2\n\ts_mov_b32 m0, %0" : "=&s"(keep) : "v"(voff), "s"(sbase), "s"(lds_dst) : "memory"); }
#ifndef PG8_OPT_Z
#define PG8_OPT_Z 1
#endif
#ifndef PG8_OPT_NEXT
#define PG8_OPT_NEXT 1
#endif
template <int N> __device__ __forceinline__ void pg8_waitv() { asm volatile("s_waitcnt vmcnt(%0)" :: "n"(N) : "memory"); }
template <class Epi, class Sched, bool ALIGN_EPI = false, bool SP2 = false, bool F8 = false>
__device__ __forceinline__ void gemm_phase(PG8_LAS unsigned char* lds, const Gemm g, const Sched& S, const Epi& E) {
    int tid_ = threadIdx.x; asm volatile("" : "+v"(tid_));
    const int tid = tid_, wid = __builtin_amdgcn_readfirstlane(tid >> 6), lane = tid & 63, wr = wid >> 2, wc = wid & 3, fr = lane & 15, fq = lane >> 4;
    const int K = F8 ? (g.K >> 1) : g.K, nt = K / BK;
    unsigned voffA[2], voffB[2];
#pragma unroll
    for (int i = 0; i < 2; ++i) { int R, C; stage_rc(tid * 16 + i * 8192, R, C); const int Rb = Epi::PERM ? ((R & ~31) + perm32(R & 31)) : R;
        voffA[i] = (unsigned)(R * K + C) * 2u; voffB[i] = (unsigned)(Rb * K + C) * 2u; }
    const size_t kstep = (size_t)(BK * 2);
    const size_t hstep = (size_t)HALF * K * 2;
    const size_t tstep = 2 * hstep;
    const unsigned ldsb = (unsigned)(size_t)lds;
    const unsigned ldsw = (unsigned)wid * 1024u;
    const int aoff = lds_byte(wr * 64 + fr, fq * 8), boff = lds_byte(wc * 32 + fr, fq * 8);
#define PG8_SA(b, h) (((b) * 2 + (h)) * HTB)
#define PG8_SB(b, h) ((4 + (b) * 2 + (h)) * HTB)
#define PG8_STAGE(bufoff, gbase, voff) do { _Pragma("unroll") for (int _i = 0; _i < 2; ++_i) \
        pg8_glds((const char*)(gbase), (voff)[_i], ldsb + (unsigned)((bufoff) + _i * 8192) + ldsw); } while (0)
#define PG8_LDA(dst, b, h) do { _Pragma("unroll") for (int m = 0; m < 4; ++m) _Pragma("unroll") for (int k = 0; k < 2; ++k) dst[m][k] = *(const PG8_LAS bf16x8*)(lds + PG8_SA(b, h) + aoff + m * 2048 + k * 1024); } while (0)
#define PG8_LDB(dst, b, h) do { _Pragma("unroll") for (int n = 0; n < 2; ++n) _Pragma("unroll") for (int k = 0; k < 2; ++k) dst[n][k] = *(const PG8_LAS bf16x8*)(lds + PG8_SB(b, h) + boff + n * 2048 + k * 1024); } while (0)
#define PG8_MMA(ai, bj, At, Bt, Z) do { __builtin_amdgcn_s_setprio(1); _Pragma("unroll") for (int m = 0; m < 4; ++m) _Pragma("unroll") for (int n = 0; n < 2; ++n) { \
        if constexpr (F8) { typedef int v8i_t __attribute__((ext_vector_type(8))); typedef int v4i_t __attribute__((ext_vector_type(4))); \
            const v4i_t b0_ = __builtin_bit_cast(v4i_t, Bt[n][0]), b1_ = __builtin_bit_cast(v4i_t, Bt[n][1]), a0_ = __builtin_bit_cast(v4i_t, At[m][0]), a1_ = __builtin_bit_cast(v4i_t, At[m][1]); \
            const v8i_t bw_ = {b0_[0], b0_[1], b0_[2], b0_[3], b1_[0], b1_[1], b1_[2], b1_[3]}, aw_ = {a0_[0], a0_[1], a0_[2], a0_[3], a1_[0], a1_[1], a1_[2], a1_[3]}; \
            if constexpr (Z) asm volatile("v_mfma_f32_16x16x128_f8f6f4 %0, %1, %2, 0" : "=v"(acc[ai][bj][m][n]) : "v"(bw_), "v"(aw_)); \
            else asm volatile("v_mfma_f32_16x16x128_f8f6f4 %0, %1, %2, %0" : "+v"(acc[ai][bj][m][n]) : "v"(bw_), "v"(aw_)); } \
        else { _Pragma("unroll") for (int k = 0; k < 2; ++k) acc[ai][bj][m][n] = __builtin_amdgcn_mfma_f32_16x16x32_bf16(Bt[n][k], At[m][k], acc[ai][bj][m][n], 0, 0, 0); } } \
        __builtin_amdgcn_s_setprio(0); } while (0)
#define PG8_WAIT_V(n) asm volatile("s_waitcnt vmcnt(" #n ")" ::: "memory")
#define PG8_WAIT_L(n) asm volatile("s_waitcnt lgkmcnt(" #n ")" ::: "memory")
#define PG8_BAR __builtin_amdgcn_s_barrier()
#define PG8_SCHED __builtin_amdgcn_sched_barrier(0)
    constexpr bool FK = F8 && SP2 && Epi::FKOK;
    constexpr bool ZF = FK && (PG8_OPT_Z != 0);
    Unit cur, nxt; int ui = 0;
    if (!S.next(0, cur)) return;
    f32x4 acc[2][2][4][2];
#pragma unroll
    for (int a = 0; a < 2; ++a)
#pragma unroll
        for (int b = 0; b < 2; ++b)
#pragma unroll
            for (int m = 0; m < 4; ++m)
#pragma unroll
                for (int n = 0; n < 2; ++n) acc[a][b][m][n] = (f32x4){0.f, 0.f, 0.f, 0.f};
    bf16x8 At[4][2], B0[2][2], B1[2][2];
    const char* cA = (const char*)g.A + (size_t)cur.pa * tstep; const char* cB = (const char*)g.Bt + (size_t)cur.pe * g.estep + (size_t)cur.pn * tstep;
    S.a_ready(cur);
    if constexpr (SP2) {
        PG8_STAGE(PG8_SB(0, 0), cB, voffB); PG8_STAGE(PG8_SB(0, 1), cB + hstep, voffB); PG8_STAGE(PG8_SA(0, 0), cA, voffA); PG8_STAGE(PG8_SA(0, 1), cA + hstep, voffA);
        if (wr == 1) PG8_BAR;
        PG8_WAIT_V(2); PG8_BAR;
        PG8_STAGE(PG8_SB(1, 0), cB + kstep, voffB); PG8_STAGE(PG8_SA(1, 0), cA + kstep, voffA); PG8_STAGE(PG8_SB(1, 1), cB + hstep + kstep, voffB);
        PG8_WAIT_V(6); PG8_BAR;
    } else {
        PG8_STAGE(PG8_SB(0, 0), cB, voffB); PG8_STAGE(PG8_SA(0, 0), cA, voffA); PG8_STAGE(PG8_SB(0, 1), cB + hstep, voffB); PG8_STAGE(PG8_SA(0, 1), cA + hstep, voffA);
        if (wr == 1) PG8_BAR;
        PG8_WAIT_V(4); PG8_BAR;
        PG8_STAGE(PG8_SB(1, 0), cB + kstep, voffB); PG8_STAGE(PG8_SA(1, 0), cA + kstep, voffA); PG8_STAGE(PG8_SB(1, 1), cB + hstep + kstep, voffB);
        PG8_WAIT_V(6); PG8_BAR;
    }
    for (;;) {
        bool has_next = false; const char* nA = cA; const char* nB = cB;
#define PG8_NEXT do { has_next = S.next(ui + 1, nxt); nA = has_next ? (const char*)g.A + (size_t)nxt.pa * tstep : cA; nB = has_next ? (const char*)g.Bt + (size_t)nxt.pe * g.estep + (size_t)nxt.pn * tstep : cB; } while (0)
        if constexpr (PG8_OPT_NEXT == 0 || !FK) PG8_NEXT;
#pragma unroll 1
        for (int t = 0; t < nt; t += 2) {
            const bool last = (t == nt - 2);
            const char* a1 = cA + (size_t)(t + 1) * kstep;
            const char* a2 = last ? nA : cA + (size_t)(t + 2) * kstep; const char* b2 = last ? nB : cB + (size_t)(t + 2) * kstep;
            const char* a3 = a2 + kstep; const char* b3 = b2 + kstep;
            if (last && has_next) S.a_ready(nxt);
            if constexpr (SP2) {
#define PG8_KT(b, AX, BN, AN, Z, FIRST) do { \
            PG8_LDB(B0, b, 0); PG8_LDB(B1, b, 1); PG8_SCHED; PG8_LDA(At, b, 0); PG8_STAGE(PG8_SA(1 - (b), 1), (AX) + hstep, voffA); \
            if (FIRST && ui > 0) pg8_waitv<8 + Epi::NST>(); else pg8_waitv<8>(); \
            PG8_WAIT_L(0); PG8_BAR; PG8_MMA(0, 0, At, B0, Z); if constexpr (FIRST && PG8_OPT_NEXT == 1) PG8_NEXT; PG8_MMA(0, 1, At, B1, Z); PG8_BAR; PG8_SCHED; \
            PG8_LDA(At, b, 1); PG8_STAGE(PG8_SB(b, 0), BN, voffB); PG8_STAGE(PG8_SB(b, 1), (BN) + hstep, voffB); PG8_STAGE(PG8_SA(b, 0), AN, voffA); \
            if (FIRST && ui > 0) pg8_waitv<8 + Epi::NST>(); else pg8_waitv<8>(); \
            PG8_WAIT_L(0); PG8_BAR; PG8_MMA(1, 0, At, B0, Z); PG8_MMA(1, 1, At, B1, Z); PG8_BAR; PG8_SCHED; } while (0)
            if constexpr (FK) { if (t == 0) PG8_KT(0, a1, b2, a2, ZF, true); else PG8_KT(0, a1, b2, a2, false, false); }
            else PG8_KT(0, a1, b2, a2, false, false);
            PG8_KT(1, a2, b3, a3, false, false);
            } else {
            if (t == 0) PG8_NEXT;
            PG8_LDB(B0, 0, 0); PG8_SCHED; PG8_LDA(At, 0, 0); PG8_STAGE(PG8_SA(1, 1), a1 + hstep, voffA);
            PG8_WAIT_L(8); PG8_BAR; PG8_WAIT_L(0); PG8_MMA(0, 0, At, B0, false); PG8_BAR; PG8_SCHED;
            PG8_LDB(B1, 0, 1); PG8_STAGE(PG8_SB(0, 0), b2, voffB);
            PG8_BAR; PG8_WAIT_L(0); PG8_MMA(0, 1, At, B1, false); PG8_BAR;
            PG8_LDA(At, 0, 1); PG8_STAGE(PG8_SA(0, 0), a2, voffA);
            PG8_BAR; PG8_WAIT_L(0); PG8_MMA(1, 0, At, B0, false); PG8_BAR; PG8_SCHED;
            PG8_STAGE(PG8_SB(0, 1), b2 + hstep, voffB);
            PG8_WAIT_V(6); PG8_BAR; PG8_MMA(1, 1, At, B1, false); PG8_BAR;
            PG8_LDB(B0, 1, 0); PG8_SCHED; PG8_LDA(At, 1, 0); PG8_STAGE(PG8_SA(0, 1), a2 + hstep, voffA);
            PG8_WAIT_L(8); PG8_BAR; PG8_WAIT_L(0); PG8_MMA(0, 0, At, B0, false); PG8_BAR; PG8_SCHED;
            PG8_LDB(B1, 1, 1); PG8_STAGE(PG8_SB(1, 0), b3, voffB);
            PG8_BAR; PG8_WAIT_L(0); PG8_MMA(0, 1, At, B1, false); PG8_BAR;
            PG8_LDA(At, 1, 1); PG8_STAGE(PG8_SA(1, 0), a3, voffA);
            PG8_BAR; PG8_WAIT_L(0); PG8_MMA(1, 0, At, B0, false); PG8_BAR; PG8_SCHED;
            PG8_STAGE(PG8_SB(1, 1), b3 + hstep, voffB);
            PG8_WAIT_V(6); PG8_BAR; PG8_MMA(1, 1, At, B1, false); PG8_BAR;
            }
        }
        if constexpr (ALIGN_EPI) { if (wr == 0) PG8_BAR; }
        if constexpr (F8) asm volatile("s_nop 15\n\ts_nop 7" ::: "memory");
        if constexpr (!Epi::AFTER_DRAIN) { int fr_ = fr, fq_ = fq; asm volatile("" : "+v"(fr_), "+v"(fq_)); E(acc, cur, wr, wc, fr_, fq_); S.done(cur); }
        if (!has_next) break;
        if constexpr (!ZF) {
#pragma unroll
        for (int a = 0; a < 2; ++a)
#pragma unroll
            for (int b = 0; b < 2; ++b)
#pragma unroll
                for (int m = 0; m < 4; ++m)
#pragma unroll
                    for (int n = 0; n < 2; ++n) acc[a][b][m][n] = (f32x4){0.f, 0.f, 0.f, 0.f}; }
        cur = nxt; cA = nA; cB = nB; ++ui;
        if constexpr (ALIGN_EPI) { if (wr == 1) PG8_BAR; }
    }
    PG8_WAIT_V(0);
    if constexpr (!ALIGN_EPI) { if (wr == 0) PG8_BAR; }
    PG8_BAR;
    if constexpr (Epi::AFTER_DRAIN) { E.fused(acc, cur, wr, wc, fr, fq, lds, wid, lane); S.done(cur); }
#undef PG8_SA
#undef PG8_SB
#undef PG8_STAGE
#undef PG8_KT
#undef PG8_NEXT
#undef PG8_LDA
#undef PG8_LDB
#undef PG8_MMA
#undef PG8_WAIT_V
#undef PG8_WAIT_L
#undef PG8_BAR
#undef PG8_SCHED
}
}

#define GAS __attribute__((address_space(1)))
#define LAS __attribute__((address_space(3)))
typedef unsigned short bf16;
typedef unsigned v4u __attribute__((ext_vector_type(4)));
typedef float f32x4 __attribute__((ext_vector_type(4)));
typedef short bf16x8 __attribute__((ext_vector_type(8)));
typedef GAS unsigned gu32;
typedef GAS unsigned long long gu64;
#define RLX_AGENT __ATOMIC_RELAXED, __HIP_MEMORY_SCOPE_AGENT
#define LDS_WAIT() asm volatile("s_waitcnt lgkmcnt(0)" ::: "memory")
#define VM_WAIT() asm volatile("s_waitcnt vmcnt(0)" ::: "memory")
__device__ __forceinline__ unsigned long long rt() { return __builtin_amdgcn_s_memrealtime(); }
__device__ __forceinline__ unsigned f2bf(float f) { unsigned u = __builtin_bit_cast(unsigned, f); return (u + 0x7fffu + ((u >> 16) & 1u)) >> 16; }
__device__ __forceinline__ unsigned pk2(float lo, float hi) { return f2bf(lo) | (f2bf(hi) << 16); }

#define XB_TMO      128
#define XB_XCNT(j)  (256  + 64 * (j))
#define XB_XSUB(j)  (1280 + 64 * (j))
#define XB_XGEN(j)  (2304 + 64 * (j))
#define XB_TOP      3328
#define XB_TOPGEN   3392
#define XCD_BAR_WORDS 3456
#define XB_SPIN_CAP (1u << 18)

__device__ __forceinline__ unsigned xb_ld(unsigned* p)              { return __hip_atomic_load(p, __ATOMIC_RELAXED, __HIP_MEMORY_SCOPE_AGENT); }
__device__ __forceinline__ unsigned xb_add(unsigned* p, unsigned v) { return __hip_atomic_fetch_add(p, v, __ATOMIC_RELAXED, __HIP_MEMORY_SCOPE_AGENT); }
__device__ __forceinline__ unsigned xb_xcc_id() { return (unsigned)__builtin_amdgcn_s_getreg((3 << 11) | 20) & 0xFu; }
#define XB_SPIN(cond, bar) do { unsigned _sp = 0; while (cond) { __builtin_amdgcn_s_sleep(1); \
    if ((++_sp & 255u) == 0u) { if (xb_ld(&(bar)[XB_TMO])) break; if (_sp > XB_SPIN_CAP) { atomicAdd(&(bar)[XB_TMO], 1u); break; } } } } while (0)

struct XcdBarrier {
    unsigned* bar; unsigned x;
    volatile LAS unsigned* st;
};

__device__ __forceinline__ XcdBarrier xcd_barrier_post(unsigned* bar, volatile LAS unsigned* st) {
    XcdBarrier b; b.bar = bar; b.x = xb_xcc_id(); b.st = st;
    if (threadIdx.x == 0) (void)xb_add(&bar[XB_XCNT(b.x)], 1u);
    return b;
}
__device__ __forceinline__ void xcd_barrier_complete(unsigned* bar, unsigned x, unsigned& nloc, unsigned& nx) {
    const unsigned G = gridDim.x * gridDim.y * gridDim.z;
    unsigned sum, cnt, mine, sp = 0u;
    for (;;) {
        sum = 0u; cnt = 0u; mine = 0u;
#pragma unroll
        for (unsigned j = 0; j < 16; ++j) { const unsigned c = xb_ld(&bar[XB_XCNT(j)]); sum += c; cnt += (c > 0u) ? 1u : 0u; mine = (j == x) ? c : mine; }
        if (sum == G) break;
        __builtin_amdgcn_s_sleep(1);
        if ((++sp & 255u) == 0u) { if (xb_ld(&bar[XB_TMO])) break; if (sp > XB_SPIN_CAP) { atomicAdd(&bar[XB_TMO], 1u); break; } }
    }
    nloc = mine > 0u ? mine : 1u; nx = cnt > 0u ? cnt : 1u;
}

__device__ __forceinline__ void xcd_barrier(const XcdBarrier& b) {
    asm volatile("s_waitcnt vmcnt(0)" ::: "memory");
    __syncthreads();
    if (threadIdx.x == 0) {
        unsigned* bar = b.bar;
        __builtin_amdgcn_s_waitcnt(0);
        unsigned nloc = b.st[0], nx = b.st[1];
        if (nloc == 0u) { xcd_barrier_complete(bar, b.x, nloc, nx); b.st[0] = nloc; b.st[1] = nx; }
        const unsigned old = xb_add(&bar[XB_XSUB(b.x)], 1u);
        const unsigned gen = old / nloc;
        if (old + 1u == (gen + 1u) * nloc) {
            __builtin_amdgcn_fence(__ATOMIC_RELEASE, "agent");
            asm volatile("s_waitcnt vmcnt(0)" ::: "memory");
            const unsigned og = xb_add(&bar[XB_TOP], 1u);
            const unsigned tg = og / nx;
            if (og + 1u == (tg + 1u) * nx) xb_add(&bar[XB_TOPGEN], 1u);
            else XB_SPIN(xb_ld(&bar[XB_TOPGEN]) == tg, bar);
            __builtin_amdgcn_fence(__ATOMIC_ACQUIRE, "agent");
            xb_add(&bar[XB_XGEN(b.x)], 1u);
            asm volatile("s_waitcnt vmcnt(0)" ::: "memory");
        } else {
            XB_SPIN(xb_ld(&bar[XB_XGEN(b.x)]) == gen, bar);
            __builtin_amdgcn_fence(__ATOMIC_ACQUIRE, "agent");
            asm volatile("s_waitcnt vmcnt(0)" ::: "memory");
        }
    }
    __syncthreads();
}


constexpr int NWAVES = 8;
constexpr int NTOK = 32768, DM = 1024, SEQ = 2048, INW = 2304, FF = 3584, NE = 8, DEPTH = 4;
constexpr int COL_K = 512, COL_V = 640, COL_CB = 768, COL_CC = 1280, COL_HC = 1792;
constexpr int MOE_TILES_CAP = 2 * NTOK / 256 + NE;
constexpr int MOE_ROWS_CAP = MOE_TILES_CAP * 256;
constexpr float EPS = 1e-5f;
constexpr float LOG2E = 1.4426950408889634f;
constexpr float QSCALE = 0.125f * LOG2E;
constexpr float SA_X = 4.f, SW_UP = 64.f, SA_ACT = 8.f, SW_DN = 128.f, S_YS = 32.f;
#ifndef DENSE_UP_F8
#define DENSE_UP_F8 3
#endif
#ifndef DENSE_DN_F8
#define DENSE_DN_F8 3
#endif
#ifndef IN_F8
#define IN_F8 8
#endif
#define INF8(l) ((IN_F8 >> (l)) & 1)
constexpr float SW_IN = 64.f;
#define UPF8(i) ((DENSE_UP_F8 >> (i)) & 1)
#define DNF8(i) ((DENSE_DN_F8 >> (i)) & 1)
#ifndef MK_PER_PHASE
#define MK_PER_PHASE 0
#endif
#ifndef ATTN_NAIVE
#define ATTN_NAIVE 0
#endif

constexpr size_t MiB = 1u << 20;
constexpr size_t WS_CTL = 0, CTL_ZERO_BYTES = 128 * 1024;
constexpr size_t WS_WIN = 1 * MiB;
constexpr size_t WS_WOUT = 19 * MiB;
constexpr size_t WS_WDUP = 27 * MiB;
constexpr size_t WS_WDDN = 55 * MiB;
constexpr size_t WS_WMUP = 69 * MiB;
constexpr size_t WS_WMDN = 181 * MiB;
constexpr size_t MOE_SET_UP = 56 * MiB, MOE_SET_DN = 28 * MiB;
constexpr int TAILCVT_KIN = 2;
constexpr int TAILCVT_K = 4;
constexpr size_t WS_ROPEC = 237 * MiB;
constexpr size_t WS_XB = 245 * MiB;
constexpr size_t WS_SSQ = 309 * MiB;
constexpr size_t WS_RT = 310 * MiB;
constexpr size_t WS_LIST = 311 * MiB;
constexpr size_t WS_ACT = 312 * MiB;
constexpr size_t WS_PROJ = WS_ACT, WS_Y = WS_ACT + 144 * MiB;
constexpr size_t WS_XS = WS_ACT + 232 * MiB;
constexpr size_t WS_XF8 = WS_ACT + 240 * MiB;
constexpr size_t WS_YS = 774 * MiB;
constexpr size_t WS_END = 906 * MiB;
static_assert(WS_ACT + (size_t)MOE_ROWS_CAP * FF * 2 <= WS_YS && WS_YS + (size_t)MOE_ROWS_CAP * DM * 2 <= WS_END, "ws map");
static_assert((size_t)NTOK * INW * 2 <= 144 * MiB, "proj fits");
static_assert((size_t)MOE_ROWS_CAP * FF <= 232 * MiB && WS_XS + (size_t)NE * NTOK * DM <= WS_END, "xs placement");
constexpr int CW_BAR = 4096;
constexpr int CW_MOECNT = 16384;

constexpr int RING_OFF = 0, RING_BYTES = 131072;
constexpr int LDSCTL_OFF = RING_BYTES, MISC_OFF = LDSCTL_OFF + 320;
constexpr int SSQT_OFF = RING_BYTES + 1024;
constexpr int LDS_BYTES = 147456;
static_assert(SSQT_OFF + 4096 <= LDS_BYTES, "LDS map");

__device__ __forceinline__ float wave_sum(float v) {
#pragma unroll
    for (int o = 1; o < 64; o <<= 1) v += __shfl_xor(v, o);
    return v;
}
__device__ __forceinline__ float wave_max(float v) {
#pragma unroll
    for (int o = 1; o < 64; o <<= 1) v = fmaxf(v, __shfl_xor(v, o));
    return v;
}
typedef unsigned v2u __attribute__((ext_vector_type(2)));
__device__ __forceinline__ float bf2f(unsigned short b) { return __builtin_bit_cast(float, (unsigned)b << 16); }
__device__ __forceinline__ float bflo(unsigned w) { return __builtin_bit_cast(float, w << 16); }
__device__ __forceinline__ float bfhi(unsigned w) { return __builtin_bit_cast(float, w & 0xffff0000u); }

__device__ __forceinline__ void tr_item(const float* W, int ldw, int k0, int n0, bf16* WT, int ldt, int r0, const float* kscale, LAS float* scr, int lane) {
#pragma unroll 8
    for (int i = 0; i < 32; ++i) { const int kk = 2 * i + (lane >> 5); float v = W[(size_t)(k0 + kk) * ldw + n0 + (lane & 31)]; if (kscale) v *= kscale[k0 + kk]; scr[kk * 33 + (lane & 31)] = v; }
    LDS_WAIT(); asm volatile("" ::: "memory");
    const int c = lane & 7;
#pragma unroll
    for (int j = 0; j < 4; ++j) { const int n = (lane >> 3) + 8 * j; const LAS float* s = scr + (8 * c) * 33 + n;
        v4u o; o.x = pk2(s[0 * 33], s[1 * 33]); o.y = pk2(s[2 * 33], s[3 * 33]); o.z = pk2(s[4 * 33], s[5 * 33]); o.w = pk2(s[6 * 33], s[7 * 33]);
        *(GAS v4u*)(WT + (size_t)(r0 + n) * ldt + k0 + 8 * c) = o; }
    LDS_WAIT(); asm volatile("" ::: "memory");
}

template <int MODE> __device__ __forceinline__ void cvt_item(const float* W, int ldw, int k0, int n0, bf16* WT, int ldt, int sel, const float* kscale, int lane) {
    const int n = n0 + 4 * lane; f32x4 v[8];
#pragma unroll
    for (int j = 0; j < 8; ++j) v[j] = *(const GAS f32x4*)(W + (size_t)(k0 + j) * ldw + n);
    if (kscale) {
#pragma unroll
        for (int j = 0; j < 8; ++j) v[j] = v[j] * kscale[k0 + j];
    }
    int r = n;
    if (MODE == 1) { const int pn = n >> 8, loc = n & 255; r = 256 * pn + 128 * ((loc >> 5) & 1) + 32 * (loc >> 6) + (loc & 31); }
    if (MODE == 2) r = 256 * (n >> 7) + 128 * sel + (n & 127);
#pragma unroll
    for (int i = 0; i < 4; ++i) { v4u o; o.x = pk2(v[0][i], v[1][i]); o.y = pk2(v[2][i], v[3][i]); o.z = pk2(v[4][i], v[5][i]); o.w = pk2(v[6][i], v[7][i]);
        *(GAS v4u*)(WT + (size_t)(r + i) * ldt + k0) = o; }
}

template <int MODE> __device__ __forceinline__ void cvt_item_f8(const float* W, int ldw, int k0, int n0, unsigned char* WT, int ldt, int sel, const float* kscale, float sc, int lane) {
    const int n = n0 + 4 * lane; f32x4 v[16];
#pragma unroll
    for (int j = 0; j < 16; ++j) v[j] = *(const GAS f32x4*)(W + (size_t)(k0 + j) * ldw + n);
#pragma unroll
    for (int j = 0; j < 16; ++j) v[j] = v[j] * (kscale ? kscale[k0 + j] * sc : sc);
    int r = n;
    if (MODE == 2) r = 256 * (n >> 7) + 128 * sel + (n & 127);
#pragma unroll
    for (int i = 0; i < 4; ++i) { v4u o; o.x = pg8::pk4_fp8(v[0][i], v[1][i], v[2][i], v[3][i]); o.y = pg8::pk4_fp8(v[4][i], v[5][i], v[6][i], v[7][i]);
        o.z = pg8::pk4_fp8(v[8][i], v[9][i], v[10][i], v[11][i]); o.w = pg8::pk4_fp8(v[12][i], v[13][i], v[14][i], v[15][i]);
        *(GAS v4u*)(WT + (size_t)(r + i) * ldt + k0) = o; }
}

struct Args { const float* in[17]; float* out; unsigned char* ws; int ph_lo, ph_hi; };
#define GIN(a, i) ((const float*)(const GAS float*)(a)->in[i])
#define GOUT(a) ((float*)(GAS float*)(a)->out)
typedef const __attribute__((address_space(4))) Args* KA;
enum { I_X = 0, I_POS, I_ANW, I_WIN, I_SINK, I_CONVW, I_HNW, I_WOUT, I_FNW, I_DG, I_DU, I_DD, I_RW, I_MG, I_MU, I_MD, I_FINW };

struct CvtT { const float* W; const float* ks; unsigned char* WT; int ldw, ldt, k0, n0, mode, sel, f8; float sc; };
__device__ __forceinline__ void cvt_ld(const CvtT& T, f32x4 (&v)[16], float& kv, int lane) {
    const float* p = T.W + (size_t)T.k0 * T.ldw + T.n0 + 4 * lane;
#pragma unroll
    for (int j = 0; j < 16; ++j) v[j] = *(const GAS f32x4*)(p + (size_t)j * T.ldw);
    kv = T.ks ? *(const GAS float*)(T.ks + T.k0 + (lane & 15)) : 1.0f;
}
__device__ __forceinline__ void cvt_st(const CvtT& T, f32x4 (&v)[16], float kv, int lane) {
    const int n = T.n0 + 4 * lane;
    const int kb = __builtin_bit_cast(int, kv * T.sc);
#pragma unroll
    for (int j = 0; j < 16; ++j) v[j] = v[j] * __builtin_bit_cast(float, __builtin_amdgcn_readlane(kb, j));
    int r = n;
    if (T.mode == 1) { const int pn = n >> 8, loc = n & 255; r = 256 * pn + 128 * ((loc >> 5) & 1) + 32 * (loc >> 6) + (loc & 31); }
    if (T.mode == 2) r = 256 * (n >> 7) + 128 * T.sel + (n & 127);
    if (T.f8) {
#pragma unroll
        for (int i = 0; i < 4; ++i) { v4u o; o.x = pg8::pk4_fp8(v[0][i], v[1][i], v[2][i], v[3][i]); o.y = pg8::pk4_fp8(v[4][i], v[5][i], v[6][i], v[7][i]);
            o.z = pg8::pk4_fp8(v[8][i], v[9][i], v[10][i], v[11][i]); o.w = pg8::pk4_fp8(v[12][i], v[13][i], v[14][i], v[15][i]);
            *(GAS v4u*)(T.WT + (size_t)(r + i) * T.ldt + T.k0) = o; }
    } else {
#pragma unroll
        for (int i = 0; i < 4; ++i) { v4u o0, o1; o0.x = pk2(v[0][i], v[1][i]); o0.y = pk2(v[2][i], v[3][i]); o0.z = pk2(v[4][i], v[5][i]); o0.w = pk2(v[6][i], v[7][i]);
            o1.x = pk2(v[8][i], v[9][i]); o1.y = pk2(v[10][i], v[11][i]); o1.z = pk2(v[12][i], v[13][i]); o1.w = pk2(v[14][i], v[15][i]);
            GAS v4u* dp = (GAS v4u*)((bf16*)T.WT + (size_t)(r + i) * T.ldt + T.k0); dp[0] = o0; dp[1] = o1; }
    }
}
template <class G> __device__ __forceinline__ void cvt_pipeline(const G& get, int cu, int NCU, int lane, int tlim = 0x7fffffff) {
    CvtT Ta, Tb; f32x4 va[16], vb[16]; float ka = 1.0f, kb = 1.0f;
    int t = cu; bool ha = t < tlim && get(t, Ta); if (ha) cvt_ld(Ta, va, ka, lane);
    while (ha) {
        t += NCU; const bool hb = t < tlim && get(t, Tb); if (hb) cvt_ld(Tb, vb, kb, lane);
        cvt_st(Ta, va, ka, lane);
        if (!hb) break;
        t += NCU; ha = t < tlim && get(t, Ta); if (ha) cvt_ld(Ta, va, ka, lane);
        cvt_st(Tb, vb, kb, lane);
    }
}
struct MoeCvt { KA a; unsigned char* ws; int i, l, wave;
    __device__ __forceinline__ bool operator()(int t, CvtT& T) const {
        constexpr int T_G = 8 * 14, T_D = 28 * 4, PER_E = 2 * T_G + T_D;
        if (t >= NE * PER_E) return false;
        const int e = t / PER_E; int r = t % PER_E;
        if (r < 2 * T_G) { const int sel = r / T_G, q = r % T_G;
            T = CvtT{GIN(a, sel ? I_MU : I_MG) + (size_t)(i * NE + e) * DM * FF, GIN(a, I_FNW) + l * DM, ws + WS_WMUP + (size_t)i * MOE_SET_UP + (size_t)e * 2 * FF * DM, FF, DM, 16 * ((q / 14) * 8 + wave), 256 * (q % 14), 2, sel, 1, SW_UP}; }
        else { r -= 2 * T_G;
            T = CvtT{GIN(a, I_MD) + (size_t)(i * NE + e) * FF * DM, nullptr, ws + WS_WMDN + (size_t)i * MOE_SET_DN + (size_t)e * DM * FF, DM, FF, 16 * ((r / 4) * 8 + wave), 256 * (r % 4), 0, 0, 1, SW_DN}; }
        return true; } };
struct ProCvt { KA a; unsigned char* ws; int wave;
    __device__ __forceinline__ bool operator()(int t, CvtT& T) const {
        constexpr int T_IN = 8 * 9, T_OUT = 8 * 4, T_G = 8 * 14, T_D = 28 * 4;
        if (t >= 4 * T_IN + 4 * T_OUT + 4 * T_G + 2 * T_D) return false;
        int r = t;
        if (r < 4 * T_IN) { const int l = r / T_IN, q = r % T_IN;
            T = CvtT{GIN(a, I_WIN) + (size_t)l * DM * INW, GIN(a, I_ANW) + l * DM, ws + WS_WIN + (size_t)l * INW * DM * 2, INW, DM, 16 * ((q / 9) * 8 + wave), 256 * (q % 9), 1, 0, INF8(l), INF8(l) ? SW_IN : 1.0f}; return true; }
        r -= 4 * T_IN;
        if (r < 4 * T_OUT) { const int l = r / T_OUT, q = r % T_OUT;
            T = CvtT{GIN(a, I_WOUT) + (size_t)l * DM * DM, nullptr, ws + WS_WOUT + (size_t)l * DM * DM * 2, DM, DM, 16 * ((q / 4) * 8 + wave), 256 * (q % 4), 0, 0, 0, 1.0f}; return true; }
        r -= 4 * T_OUT;
        if (r < 4 * T_G) { const int sel = r / (2 * T_G), rr = r % (2 * T_G), i = rr / T_G, q = rr % T_G; const int f8 = UPF8(i);
            T = CvtT{GIN(a, sel ? I_DU : I_DG) + (size_t)i * DM * FF, GIN(a, I_FNW) + (2 * i) * DM, ws + WS_WDUP + (size_t)i * 2 * FF * DM * 2, FF, DM, 16 * ((q / 14) * 8 + wave), 256 * (q % 14), 2, sel, f8, f8 ? SW_UP : 1.0f}; return true; }
        r -= 4 * T_G;
        { const int i = r / T_D, q = r % T_D; const int f8 = DNF8(i);
            T = CvtT{GIN(a, I_DD) + (size_t)i * FF * DM, nullptr, ws + WS_WDDN + (size_t)i * DM * FF * 2, DM, FF, 16 * ((q / 4) * 8 + wave), 256 * (q % 4), 0, 0, f8, f8 ? SW_DN : 1.0f}; return true; } } };

__device__ const double INVF_REV[32] = {
    0.15915494309189535, 0.11934937021124886, 0.08949940160889101, 0.06711508300522726,
    0.050329212104487035, 0.03774158471741977, 0.0283021958306234, 0.02122365276477766,
    0.015915494309189534, 0.011934937021124886, 0.008949940160889102, 0.006711508300522725,
    0.005032921210448704, 0.003774158471741977, 0.00283021958306234, 0.0021223652764777662,
    0.0015915494309189536, 0.0011934937021124885, 0.0008949940160889102, 0.0006711508300522726,
    0.0005032921210448703, 0.00037741584717419774, 0.00028302195830623395, 0.0002122365276477766,
    0.00015915494309189535, 0.00011934937021124886, 8.949940160889102e-05, 6.711508300522725e-05,
    5.0329212104487035e-05, 3.774158471741978e-05, 2.8302195830623396e-05, 2.122365276477766e-05
};

__device__ __forceinline__ void p_prologue(KA a, unsigned char* ws, LAS unsigned char* lds, int gw, int NGW, int wave, int lane, int gtid, int NGT) {
    { const ProCvt get{a, ws, wave}; cvt_pipeline(get, gw >> 3, NGW >> 3, lane); }
    { const int* pos = (const int*)GIN(a, I_POS); unsigned* rcs = (unsigned*)(ws + WS_ROPEC);
      for (int i = gtid; i < NTOK * 32; i += NGT) { const int t = i >> 5, j = i & 31; double r = (double)pos[t] * INVF_REV[j]; r -= floor(r);
          const float rf = (float)r; const _Float16 ch = (_Float16)__builtin_amdgcn_cosf(rf), sh = (_Float16)__builtin_amdgcn_sinf(rf);
          rcs[i] = (unsigned)__builtin_bit_cast(unsigned short, ch) | ((unsigned)__builtin_bit_cast(unsigned short, sh) << 16); } }
    { const float* x = GIN(a, I_X); bf16* xb = (bf16*)(ws + WS_XB); float* ssq = (float*)(ws + WS_SSQ);
      for (int m0 = gw; m0 < NTOK; m0 += 4 * NGW) {
          f32x4 v[4][4];
#pragma unroll
          for (int b = 0; b < 4; ++b) { const int m = (m0 + b * NGW < NTOK) ? m0 + b * NGW : m0; const GAS f32x4* xr = (const GAS f32x4*)(x + (size_t)m * DM) + lane;
#pragma unroll
              for (int j = 0; j < 4; ++j) v[b][j] = xr[64 * j]; }
#pragma unroll
          for (int b = 0; b < 4; ++b) { const int m = m0 + b * NGW; if (m < NTOK) { float s = 0.f;
#pragma unroll
              for (int j = 0; j < 4; ++j) s += (v[b][j].x * v[b][j].x + v[b][j].y * v[b][j].y) + (v[b][j].z * v[b][j].z + v[b][j].w * v[b][j].w);
              s = wave_sum(s);
              GAS unsigned long long* o8 = (GAS unsigned long long*)(xb + (size_t)m * DM) + lane;
#pragma unroll
              for (int j = 0; j < 4; ++j) o8[64 * j] = (unsigned long long)pk2(v[b][j].x, v[b][j].y) | ((unsigned long long)pk2(v[b][j].z, v[b][j].w) << 32);
              if (lane == 0) *(GAS f32x4*)(ssq + (size_t)m * 4) = (f32x4){s, 0.f, 0.f, 0.f}; } } } }
}

__device__ __forceinline__ void p_moe_weights(KA a, unsigned char* ws, LAS unsigned char* lds, int i, int gw, int NGW, int wave, int lane, int t0 = 0) {
    const MoeCvt get{a, ws, i, 2 * i + 1, wave}; cvt_pipeline(get, t0 + (gw >> 3), NGW >> 3, lane);
}

__device__ __forceinline__ void attn_naive_item(int t, int g, const bf16* P, const float* sinks, const float* hnw, bf16* Y, LAS float* sc, int lane) {
    const int s = t & (SEQ - 1); const int nk = (s + 1 < 128) ? (s + 1) : 128;
    { const uint2 raw = *(const uint2*)(P + (size_t)t * INW + g * 256 + lane * 4);
      sc[lane * 4 + 0] = bflo(raw.x); sc[lane * 4 + 1] = bfhi(raw.x); sc[lane * 4 + 2] = bflo(raw.y); sc[lane * 4 + 3] = bfhi(raw.y); }
    LDS_WAIT(); asm volatile("" ::: "memory");
    float d[2][4];
#pragma unroll
    for (int kk = 0; kk < 2; ++kk) {
        const int kidx = lane + 64 * kk;
#pragma unroll
        for (int h = 0; h < 4; ++h) d[kk][h] = 0.f;
        if (kidx < nk) {
            const bf16* kp = P + (size_t)(t - kidx) * INW + COL_K + g * 64;
#pragma unroll
            for (int c = 0; c < 8; ++c) { const uint4 raw = *(const uint4*)(kp + 8 * c);
                const float kf[8] = {bflo(raw.x), bfhi(raw.x), bflo(raw.y), bfhi(raw.y), bflo(raw.z), bfhi(raw.z), bflo(raw.w), bfhi(raw.w)};
#pragma unroll
                for (int h = 0; h < 4; ++h)
#pragma unroll
                    for (int e = 0; e < 8; ++e) d[kk][h] += kf[e] * sc[h * 64 + 8 * c + e]; }
        } else {
#pragma unroll
            for (int h = 0; h < 4; ++h) d[kk][h] = -INFINITY;
        }
    }
    float inv_l[4];
#pragma unroll
    for (int h = 0; h < 4; ++h) {
        const float sk = sinks[4 * g + h] * LOG2E;
        const float m = fmaxf(wave_max(fmaxf(d[0][h], d[1][h])), sk);
        const float p0 = __builtin_amdgcn_exp2f(d[0][h] - m), p1 = __builtin_amdgcn_exp2f(d[1][h] - m);
        const float l = wave_sum(p0 + p1) + __builtin_amdgcn_exp2f(sk - m);
        sc[256 + h * 128 + lane] = p0; sc[256 + h * 128 + 64 + lane] = p1; inv_l[h] = 1.0f / l;
    }
    LDS_WAIT(); asm volatile("" ::: "memory");
    float o[4] = {0.f, 0.f, 0.f, 0.f};
    const bf16* vp = P + (size_t)t * INW + COL_V + g * 64 + lane;
    for (int key = 0; key < nk; ++key) { const float v = bf2f(vp[-(ptrdiff_t)key * INW]);
#pragma unroll
        for (int h = 0; h < 4; ++h) o[h] += sc[256 + h * 128 + key] * v; }
#pragma unroll
    for (int h = 0; h < 4; ++h) { const float ov = o[h] * inv_l[h]; const float ss = wave_sum(ov * ov); const float r = __builtin_amdgcn_rsqf(ss * (1.0f / 64.0f) + EPS);
        const int col = (4 * g + h) * 64 + lane; Y[(size_t)t * DM + col] = (bf16)f2bf(ov * r * hnw[col]); }
    LDS_WAIT(); asm volatile("" ::: "memory");
}
typedef float f32x16 __attribute__((ext_vector_type(16)));
typedef short s16x4 __attribute__((ext_vector_type(4)));
__device__ __forceinline__ s16x4 vtr(const LAS unsigned char* p) { return __builtin_bit_cast(s16x4, __builtin_amdgcn_ds_read_tr16_b64_v4i16((LAS s16x4*)p)); }
__device__ __forceinline__ unsigned cvtpk(float lo, float hi) { unsigned r; asm volatile("v_cvt_pk_bf16_f32 %0, %1, %2" : "=v"(r) : "v"(lo), "v"(hi)); return r; }
__device__ __forceinline__ void attn_unit(int b, int g, int qb, const bf16* P, const float* sinks, const float* hnw, bf16* Y, LAS unsigned char* lds, int wave, int lane) {
    const int tokb = b * SEQ + qb * 128;
#pragma unroll
    for (int i = 0; i < 8; ++i) {
        const int piece = wave * 8 + i, isV = piece >> 5, pp = piece & 31, slot = pp * 64 + lane, kk = slot >> 3, cs = slot & 7;
        const int c = isV ? (cs ^ (4 * ((kk >> 1) & 1))) : (cs ^ ((kk >> 1) & 7));
        int tok = tokb - 128 + kk; if (qb == 0 && kk < 128) tok += 128;
        const bf16* src = P + (size_t)tok * INW + (isV ? COL_V : COL_K) + g * 64 + 8 * c;
        __builtin_amdgcn_global_load_lds((const unsigned*)src, (LAS unsigned*)(lds + isV * 32768 + pp * 1024), 16, 0, 0);
    }
    const int h = 4 * g + (wave >> 1), hw = wave & 1, r = lane & 31, hh = lane >> 5;
    const float sk = sinks[h] * LOG2E;
    const int kswz = (r >> 1) & 7;
    const int q4 = (lane & 15) >> 2, sw = (q4 >> 1) & 1, xoff = 32 * ((lane >> 4) & 1) + 8 * (lane & 3);
    const int voff0 = 64 * sw + xoff, voff1 = 64 * (1 - sw) + xoff;
    asm volatile("s_waitcnt vmcnt(0)" ::: "memory"); __builtin_amdgcn_s_barrier(); asm volatile("" ::: "memory");
#pragma unroll 1
    for (int sb = 0; sb < 2; ++sb) {
        const int T0 = 2 * hw + sb;
        const int tok = tokb + 32 * T0 + r;
        const bf16* qrow = P + (size_t)tok * INW + h * 64 + 8 * hh;
        bf16x8 qf[4];
#pragma unroll
        for (int ds = 0; ds < 4; ++ds) qf[ds] = *(const bf16x8*)(qrow + 16 * ds);
        f32x16 st[5];
        const LAS unsigned char* kr = lds + (32 * T0 + r) * 128;
#pragma unroll
        for (int ti = 0; ti < 5; ++ti) {
            f32x16 acc = {0.f, 0.f, 0.f, 0.f, 0.f, 0.f, 0.f, 0.f, 0.f, 0.f, 0.f, 0.f, 0.f, 0.f, 0.f, 0.f};
#pragma unroll
            for (int ds = 0; ds < 4; ++ds) { const bf16x8 a = *(const LAS bf16x8*)(kr + ti * 4096 + (((2 * ds + hh) ^ kswz) << 4)); acc = __builtin_amdgcn_mfma_f32_32x32x16_bf16(a, qf[ds], acc, 0, 0, 0); }
            st[ti] = acc;
        }
        float m = -INFINITY;
#pragma unroll
        for (int ti = 0; ti < 5; ++ti)
#pragma unroll
            for (int rg = 0; rg < 16; ++rg) { const int cr = (rg & 3) + 8 * (rg >> 2) + 4 * hh; bool vis = true;
                if (ti == 0) vis = cr > r; if (ti == 4) vis = cr <= r; if (qb == 0 && T0 + ti < 4) vis = false;
                const float sv = vis ? st[ti][rg] : -INFINITY; st[ti][rg] = sv; m = fmaxf(m, sv); }
        m = fmaxf(m, __shfl_xor(m, 32)); m = fmaxf(m, sk);
        float l = 0.f;
#pragma unroll
        for (int ti = 0; ti < 5; ++ti)
#pragma unroll
            for (int rg = 0; rg < 16; ++rg) { const float pv = __builtin_amdgcn_exp2f(st[ti][rg] - m); st[ti][rg] = pv; l += pv; }
        l += __shfl_xor(l, 32); l += __builtin_amdgcn_exp2f(sk - m);
        f32x16 o0 = {0.f, 0.f, 0.f, 0.f, 0.f, 0.f, 0.f, 0.f, 0.f, 0.f, 0.f, 0.f, 0.f, 0.f, 0.f, 0.f}, o1 = o0;
        const LAS unsigned char* vb = lds + 32768 + T0 * 4096 + (4 * hh + q4) * 128;
#pragma unroll
        for (int ti = 0; ti < 5; ++ti)
#pragma unroll
            for (int ks = 0; ks < 2; ++ks) {
                v4u pw; pw.x = cvtpk(st[ti][8 * ks + 0], st[ti][8 * ks + 1]); pw.y = cvtpk(st[ti][8 * ks + 2], st[ti][8 * ks + 3]); pw.z = cvtpk(st[ti][8 * ks + 4], st[ti][8 * ks + 5]); pw.w = cvtpk(st[ti][8 * ks + 6], st[ti][8 * ks + 7]);
                const bf16x8 pf = __builtin_bit_cast(bf16x8, pw);
                const LAS unsigned char* vp = vb + ti * 4096 + ks * 2048;
                { const s16x4 lo = vtr(vp + voff0), hi = vtr(vp + 1024 + voff0); const bf16x8 vf = {lo[0], lo[1], lo[2], lo[3], hi[0], hi[1], hi[2], hi[3]}; o0 = __builtin_amdgcn_mfma_f32_32x32x16_bf16(vf, pf, o0, 0, 0, 0); }
                { const s16x4 lo = vtr(vp + voff1), hi = vtr(vp + 1024 + voff1); const bf16x8 vf = {lo[0], lo[1], lo[2], lo[3], hi[0], hi[1], hi[2], hi[3]}; o1 = __builtin_amdgcn_mfma_f32_32x32x16_bf16(vf, pf, o1, 0, 0, 0); }
            }
        const float il = 1.0f / l; float ss = 0.f;
#pragma unroll
        for (int rg = 0; rg < 16; ++rg) { o0[rg] *= il; o1[rg] *= il; ss += o0[rg] * o0[rg] + o1[rg] * o1[rg]; }
        ss += __shfl_xor(ss, 32);
        const float rn = __builtin_amdgcn_rsqf(ss * (1.0f / 64.0f) + EPS);
        bf16* yrow = Y + (size_t)tok * DM + h * 64 + 4 * hh; const float* wrow = hnw + h * 64 + 4 * hh;
#pragma unroll
        for (int q = 0; q < 4; ++q) {
            const f32x4 w0 = *(const f32x4*)(wrow + 8 * q), w1 = *(const f32x4*)(wrow + 32 + 8 * q);
            v2u a; a.x = cvtpk(o0[4 * q + 0] * rn * w0[0], o0[4 * q + 1] * rn * w0[1]); a.y = cvtpk(o0[4 * q + 2] * rn * w0[2], o0[4 * q + 3] * rn * w0[3]);
            v2u c; c.x = cvtpk(o1[4 * q + 0] * rn * w1[0], o1[4 * q + 1] * rn * w1[1]); c.y = cvtpk(o1[4 * q + 2] * rn * w1[2], o1[4 * q + 3] * rn * w1[3]);
            *(GAS v2u*)(yrow + 8 * q) = a; *(GAS v2u*)(yrow + 32 + 8 * q) = c;
        }
    }
    asm volatile("s_waitcnt lgkmcnt(0)" ::: "memory"); __builtin_amdgcn_s_barrier(); asm volatile("" ::: "memory");
}
__device__ __forceinline__ void load_u8(const bf16* P, int t, int ch, float* u) {
    const uint4 c = *(const uint4*)(P + (size_t)t * INW + COL_CC + ch); const uint4 h = *(const uint4*)(P + (size_t)t * INW + COL_HC + ch);
    u[0] = bflo(c.x) * bflo(h.x); u[1] = bfhi(c.x) * bfhi(h.x); u[2] = bflo(c.y) * bflo(h.y); u[3] = bfhi(c.y) * bfhi(h.y);
    u[4] = bflo(c.z) * bflo(h.z); u[5] = bfhi(c.z) * bfhi(h.z); u[6] = bflo(c.w) * bflo(h.w); u[7] = bfhi(c.w) * bfhi(h.w);
}
__device__ __forceinline__ void conv_item(int t0, const bf16* P, const float* cw  , const float* hnw  , bf16* Y, int lane) {
    const int ch = 8 * lane; float w0[8], w1[8], w2[8], hw[8], u1[8], u2[8];
#pragma unroll
    for (int i = 0; i < 8; ++i) { w0[i] = cw[ch + i]; w1[i] = cw[512 + ch + i]; w2[i] = cw[1024 + ch + i]; hw[i] = hnw[512 + ch + i]; u1[i] = 0.f; u2[i] = 0.f; }
    if ((t0 & (SEQ - 1)) != 0) { load_u8(P, t0 - 1, ch, u1); load_u8(P, t0 - 2, ch, u2); }
    for (int tb = t0; tb < t0 + 16; tb += 4) {
        uint4 cc[4], hh[4], bb[4];
#pragma unroll
        for (int q = 0; q < 4; ++q) { const bf16* row = P + (size_t)(tb + q) * INW + ch; cc[q] = *(const uint4*)(row + COL_CC); hh[q] = *(const uint4*)(row + COL_HC); bb[q] = *(const uint4*)(row + COL_CB); }
#pragma unroll
        for (int q = 0; q < 4; ++q) { const int t = tb + q; const uint4 c = cc[q], h = hh[q], b = bb[q];
            const float u[8] = {bflo(c.x) * bflo(h.x), bfhi(c.x) * bfhi(h.x), bflo(c.y) * bflo(h.y), bfhi(c.y) * bfhi(h.y), bflo(c.z) * bflo(h.z), bfhi(c.z) * bfhi(h.z), bflo(c.w) * bflo(h.w), bfhi(c.w) * bfhi(h.w)};
            const float gb[8] = {bflo(b.x), bfhi(b.x), bflo(b.y), bfhi(b.y), bflo(b.z), bfhi(b.z), bflo(b.w), bfhi(b.w)};
            float o[8]; float ss = 0.f;
#pragma unroll
            for (int i = 0; i < 8; ++i) { o[i] = gb[i] * (w0[i] * u2[i] + w1[i] * u1[i] + w2[i] * u[i]); ss += o[i] * o[i]; }
            ss += __shfl_xor(ss, 1); ss += __shfl_xor(ss, 2); ss += __shfl_xor(ss, 4);
            const float r = __builtin_amdgcn_rsqf(ss * (1.0f / 64.0f) + EPS);
            v4u w; w.x = pk2(o[0] * r * hw[0], o[1] * r * hw[1]); w.y = pk2(o[2] * r * hw[2], o[3] * r * hw[3]); w.z = pk2(o[4] * r * hw[4], o[5] * r * hw[5]); w.w = pk2(o[6] * r * hw[6], o[7] * r * hw[7]);
            *(GAS v4u*)(Y + (size_t)t * DM + 512 + ch) = w;
#pragma unroll
            for (int i = 0; i < 8; ++i) { u2[i] = u1[i]; u1[i] = u[i]; } }
    }
}

struct MoeMeta { int cnt[8]; int rowstart[8]; int tend[8]; int ntiles; };
__device__ __forceinline__ MoeMeta moe_meta(gu32* ctl, int i) {
    MoeMeta m; int acc = 0;
#pragma unroll
    for (int e = 0; e < 8; ++e) { m.cnt[e] = __builtin_amdgcn_readfirstlane((int)__hip_atomic_load(ctl + CW_MOECNT + (i * 8 + e) * 64, RLX_AGENT)); m.rowstart[e] = acc * 256; acc += (m.cnt[e] + 255) >> 8; m.tend[e] = acc; }
    m.ntiles = acc; return m;
}
__device__ __forceinline__ int tailcvt_idle_in(int G) { const int r = ((NTOK / 256) * (INW / 256)) % G; return r != 0 ? G - r : 0; }
__device__ __forceinline__ int tailcvt_idle(gu32* ctl, int G) { const MoeMeta m0 = moe_meta(ctl, 0); const int nu = m0.ntiles * 4, r = nu % G; return (DEPTH >= 4 && r != 0) ? G - r : 0; }
__device__ __forceinline__ void p_router(KA a, unsigned char* ws, LAS unsigned char* lds, gu32* ctl, const bf16* XBm, int l, int i, int ci, int wave, int lane, int tid, int G) {
    LAS int* lcnt = (LAS int*)(lds + SSQT_OFF);
    LAS int* ltok = (LAS int*)(lds + SSQT_OFF + 256);
    LAS unsigned* lrow = (LAS unsigned*)(lds + RING_OFF);
    const int TPB = (NTOK + G - 1) / G, tb = blockIdx.x * TPB, te = (tb + TPB < NTOK) ? tb + TPB : NTOK;
    if (tid < 16) lcnt[tid] = 0;
    __syncthreads();
    int* tok_e = (int*)(ws + WS_RT); float* tok_g = (float*)(ws + WS_RT + 512 * 1024);
    float w[2][8][8];
    { const float* rw = GIN(a, I_RW) + (size_t)i * DM * NE; const float* nw = GIN(a, I_FNW) + l * DM;
#pragma unroll
      for (int j = 0; j < 2; ++j)
#pragma unroll
          for (int c = 0; c < 8; ++c) { const int d = 8 * lane + 512 * j + c; const float n = nw[d]; const f32x4 r0 = *(const f32x4*)(rw + d * 8), r1 = *(const f32x4*)(rw + d * 8 + 4);
              w[j][c][0] = r0.x * n; w[j][c][1] = r0.y * n; w[j][c][2] = r0.z * n; w[j][c][3] = r0.w * n; w[j][c][4] = r1.x * n; w[j][c][5] = r1.y * n; w[j][c][6] = r1.z * n; w[j][c][7] = r1.w * n; } }
    for (int t0 = tb + wave; t0 < te; t0 += 2 * NWAVES) {
        v4u xr2[2][2];
#pragma unroll
        for (int b = 0; b < 2; ++b) { const int t = (t0 + b * NWAVES < te) ? t0 + b * NWAVES : t0; const GAS v4u* xr = (const GAS v4u*)(XBm + (size_t)t * DM) + lane;
#pragma unroll
            for (int j = 0; j < 2; ++j) xr2[b][j] = xr[64 * j]; }
#pragma unroll
        for (int b = 0; b < 2; ++b) { const int t = t0 + b * NWAVES; if (t < te) {
        float s = 0.f; float lg[8] = {0.f, 0.f, 0.f, 0.f, 0.f, 0.f, 0.f, 0.f}; float xv[2][8];
#pragma unroll
        for (int j = 0; j < 2; ++j) { const v4u r = xr2[b][j];
            xv[j][0] = bflo(r.x); xv[j][1] = bfhi(r.x); xv[j][2] = bflo(r.y); xv[j][3] = bfhi(r.y); xv[j][4] = bflo(r.z); xv[j][5] = bfhi(r.z); xv[j][6] = bflo(r.w); xv[j][7] = bfhi(r.w); }
#pragma unroll
        for (int j = 0; j < 2; ++j)
#pragma unroll
            for (int c = 0; c < 8; ++c) { const float v = xv[j][c]; s += v * v;
#pragma unroll
                for (int e = 0; e < 8; ++e) lg[e] += v * w[j][c][e]; }
        s = wave_sum(s); const float rstd = 1.0f / sqrtf(s * (1.0f / DM) + EPS);
#pragma unroll
        for (int e = 0; e < 8; ++e) lg[e] = wave_sum(lg[e]) * rstd;
        { LAS v2u* o8 = (LAS v2u*)(lrow + (t - tb) * 256) + lane; const float rq = rstd * SA_X;
#pragma unroll
          for (int j = 0; j < 2; ++j) { v2u o; o.x = pg8::pk4_fp8(xv[j][0] * rq, xv[j][1] * rq, xv[j][2] * rq, xv[j][3] * rq); o.y = pg8::pk4_fp8(xv[j][4] * rq, xv[j][5] * rq, xv[j][6] * rq, xv[j][7] * rq); o8[64 * j] = o; } }
        int e0 = 0; float l0 = lg[0];
#pragma unroll
        for (int e = 1; e < 8; ++e) if (lg[e] > l0) { l0 = lg[e]; e0 = e; }
        int e1 = -1; float l1 = -INFINITY;
#pragma unroll
        for (int e = 0; e < 8; ++e) if (e != e0 && lg[e] > l1) { l1 = lg[e]; e1 = e; }
        const float ex = __expf(l1 - l0), g0 = 1.0f / (1.0f + ex), g1 = ex * g0;
        if (lane == 0) {
            const int r0 = __hip_atomic_fetch_add(lcnt + e0, 1, __ATOMIC_RELAXED, __HIP_MEMORY_SCOPE_WORKGROUP), r1 = __hip_atomic_fetch_add(lcnt + e1, 1, __ATOMIC_RELAXED, __HIP_MEMORY_SCOPE_WORKGROUP);
            const int tl = t - tb; ltok[tl * 4 + 0] = e0; ltok[tl * 4 + 1] = e1; ltok[tl * 4 + 2] = r0; ltok[tl * 4 + 3] = r1;
            tok_e[t * 2 + 0] = e0; tok_e[t * 2 + 1] = e1; tok_g[t * 2 + 0] = g0; tok_g[t * 2 + 1] = g1;
        }
        } }
    }
    __syncthreads();
    if (tid < 8) lcnt[8 + tid] = (int)__hip_atomic_fetch_add(ctl + CW_MOECNT + (ci * 8 + tid) * 64, (unsigned)lcnt[tid], RLX_AGENT);
    __syncthreads();
    int* tok_pos = (int*)(ws + WS_RT + 256 * 1024);
    for (int tl = tid; tl < te - tb; tl += NWAVES * 64) {
#pragma unroll
        for (int k = 0; k < 2; ++k) { const int e = ltok[tl * 4 + k], pos = lcnt[8 + e] + ltok[tl * 4 + 2 + k]; tok_pos[(tb + tl) * 2 + k] = pos; }
    }
    unsigned char* xs = ws + WS_XS;
    for (int a0 = wave; a0 < 2 * (te - tb); a0 += 8 * NWAVES) {
        v4u d[8]; size_t dst[8];
#pragma unroll
        for (int q = 0; q < 8; ++q) { const int as = a0 + q * NWAVES; const int asc = (as < 2 * (te - tb)) ? as : a0; const int tl = asc >> 1, k = asc & 1;
            const int e = ltok[tl * 4 + k], pos = lcnt[8 + e] + ltok[tl * 4 + 2 + k];
            d[q] = *((const LAS v4u*)(lrow + tl * 256) + lane); dst[q] = ((size_t)e * NTOK + pos) * DM; }
#pragma unroll
        for (int q = 0; q < 8; ++q) { const int as = a0 + q * NWAVES; if (as < 2 * (te - tb)) *((GAS v4u*)(xs + dst[q]) + lane) = d[q]; }
    }
    __syncthreads();
}
__device__ __forceinline__ void fp8x4_to_f32(unsigned w, float* o) {
    typedef float f2 __attribute__((ext_vector_type(2)));
    const f2 a = __builtin_amdgcn_cvt_pk_f32_fp8((int)w, false), b = __builtin_amdgcn_cvt_pk_f32_fp8((int)w, true);
    o[0] = a.x; o[1] = a.y; o[2] = b.x; o[3] = b.y;
}
__device__ __forceinline__ void p_combine(KA a, unsigned char* ws, gu32* ctl, bf16* XBm, float* OUT, float* ssq, int i, bool last, int gw, int NGW, int lane) {
    const MoeMeta mm = moe_meta(ctl, i);
    const int* tok_e = (const int*)(ws + WS_RT); const int* tok_pos = (const int*)(ws + WS_RT + 256 * 1024); const float* tok_g = (const float*)(ws + WS_RT + 512 * 1024);
    const unsigned char* ys = ws + WS_YS; const float* fw = GIN(a, I_FINW);
    constexpr int NB = 2;
    for (int t0 = gw; t0 < NTOK; t0 += NB * NGW) {
        int row[NB][2]; float g[NB][2];
#pragma unroll
        for (int b = 0; b < NB; ++b) { const int t = (t0 + b * NGW < NTOK) ? t0 + b * NGW : t0;
#pragma unroll
            for (int k = 0; k < 2; ++k) { const int e = tok_e[t * 2 + k]; int rs0 = 0;
#pragma unroll
                for (int j = 0; j < 8; ++j) if (j == e) rs0 = mm.rowstart[j];
                row[b][k] = rs0 + tok_pos[t * 2 + k]; g[b][k] = tok_g[t * 2 + k] * (1.0f / S_YS); } }
        v4u x[NB][2], p[NB], q[NB];
#pragma unroll
        for (int b = 0; b < NB; ++b) { const int t = (t0 + b * NGW < NTOK) ? t0 + b * NGW : t0;
            const GAS v4u* xr = (const GAS v4u*)(XBm + (size_t)t * DM) + 2 * lane;
            x[b][0] = xr[0]; x[b][1] = xr[1];
            p[b] = *((const GAS v4u*)(ys + (size_t)row[b][0] * DM) + lane); q[b] = *((const GAS v4u*)(ys + (size_t)row[b][1] * DM) + lane); }
#pragma unroll
        for (int b = 0; b < NB; ++b) { const int t = t0 + b * NGW; if (t < NTOK) {
            float v[16]; float s = 0.f;
#pragma unroll
            for (int c = 0; c < 4; ++c) { float pf[4], qf[4]; fp8x4_to_f32(p[b][c], pf); fp8x4_to_f32(q[b][c], qf);
                const unsigned x0 = x[b][c >> 1][2 * (c & 1)], x1 = x[b][c >> 1][2 * (c & 1) + 1];
                v[4 * c + 0] = bflo(x0) + (g[b][0] * pf[0] + g[b][1] * qf[0]); v[4 * c + 1] = bfhi(x0) + (g[b][0] * pf[1] + g[b][1] * qf[1]);
                v[4 * c + 2] = bflo(x1) + (g[b][0] * pf[2] + g[b][1] * qf[2]); v[4 * c + 3] = bfhi(x1) + (g[b][0] * pf[3] + g[b][1] * qf[3]); }
#pragma unroll
            for (int c = 0; c < 16; ++c) s += v[c] * v[c];
            s = wave_sum(s);
            if (last) {
                const float r = 1.0f / sqrtf(s * (1.0f / DM) + EPS);
                const GAS f32x4* wp = (const GAS f32x4*)(fw + 16 * lane); GAS f32x4* op = (GAS f32x4*)(OUT + (size_t)t * DM + 16 * lane);
#pragma unroll
                for (int c = 0; c < 4; ++c) { const f32x4 w4 = wp[c]; op[c] = (f32x4){v[4 * c] * r * w4.x, v[4 * c + 1] * r * w4.y, v[4 * c + 2] * r * w4.z, v[4 * c + 3] * r * w4.w}; }
            } else {
                GAS v4u* xo = (GAS v4u*)(XBm + (size_t)t * DM) + 2 * lane;
                v4u o0, o1; o0.x = pk2(v[0], v[1]); o0.y = pk2(v[2], v[3]); o0.z = pk2(v[4], v[5]); o0.w = pk2(v[6], v[7]); o1.x = pk2(v[8], v[9]); o1.y = pk2(v[10], v[11]); o1.z = pk2(v[12], v[13]); o1.w = pk2(v[14], v[15]);
                xo[0] = o0; xo[1] = o1;
                if (lane == 0) *(GAS f32x4*)(ssq + (size_t)t * 4) = (f32x4){s, 0.f, 0.f, 0.f};
            } } }
    }
}

#define PHASE_ENV() KA ap = ap0; GAS unsigned char* wsg_ = (GAS unsigned char*)ws0; int l = l0, G = G0, bx = bx0; asm volatile("" : "+s"(ap), "+s"(wsg_), "+s"(l), "+s"(G), "+s"(bx)); unsigned char* ws = (unsigned char*)wsg_; int tid = tid0, wave = wave0, gw = gw0, NGW = NGW0; asm volatile("" : "+v"(tid), "+s"(wave), "+s"(gw), "+s"(NGW)); int lane = tid & 63; (void)tid; (void)lane; (void)wave; (void)gw; (void)NGW; gu32* ctl = (gu32*)(ws + WS_CTL); (void)ctl; (void)l; (void)G; (void)bx
__global__ void __launch_bounds__(NWAVES * 64, 2) fwd_kernel(Args args) {
    extern __shared__ __attribute__((aligned(16))) unsigned char lds_raw[];
    LAS unsigned char* lds = (LAS unsigned char*)lds_raw;
    asm volatile("s_setreg_imm32_b32 hwreg(HW_REG_MODE, 23, 1), 1");
    volatile LAS unsigned* MISC = (volatile LAS unsigned*)(lds + MISC_OFF);
    const int tid0 = threadIdx.x, wave0 = __builtin_amdgcn_readfirstlane(tid0 >> 6);
    const int G0 = gridDim.x; const int bx0 = blockIdx.x;
    const int vcu = (G0 % 8 == 0) ? (bx0 % 8) * (G0 / 8) + bx0 / 8 : bx0;
    const int gw0 = vcu * NWAVES + wave0, NGW0 = G0 * NWAVES;
    const KA ap0 = (KA)__builtin_amdgcn_kernarg_segment_ptr();
    unsigned char* const ws0 = ap0->ws;
    for (int u = tid0; u < (LDS_BYTES - LDSCTL_OFF) / 4; u += NWAVES * 64) ((LAS unsigned*)(lds + LDSCTL_OFF))[u] = 0u;
    __syncthreads();
    const int lo = ap0->ph_lo, hi = ap0->ph_hi;
    XcdBarrier bar; bar.bar = (unsigned*)(ws0 + WS_CTL) + CW_BAR; bar.x = 0; bar.st = nullptr;
    if (hi - lo > 1) bar = xcd_barrier_post((unsigned*)(ws0 + WS_CTL) + CW_BAR, MISC + 8);
#define PH(p) (lo <= (p) && (p) < hi)
#define SEAM(p) do { if ((p) + 1 < hi) { XcdBarrier b_ = bar; asm volatile("" : "+s"(b_.bar), "+s"(b_.x)); xcd_barrier(b_); } } while (0)
    int pid = 0;
    if (PH(pid)) { const int l0 = 0; PHASE_ENV(); p_prologue(ap, ws, lds, gw, NGW, wave, lane, bx * (NWAVES * 64) + tid, G * NWAVES * 64); SEAM(pid); }
    ++pid;
    for (int l0 = 0; l0 < DEPTH; ++l0) {
        if (PH(pid)) { PHASE_ENV();
            pg8::StaticOrder S; S.init(NTOK, INW, G, bx);
            if (IN_F8 != 0 && INF8(l)) {
                pg8::Gemm g{(const bf16*)(ws + WS_XF8), (const bf16*)(ws + WS_WIN + (size_t)l * INW * DM * 2), NTOK, INW, DM, 0};
                pg8::EpiIn E{(bf16*)(ws + WS_PROJ), (const float*)(ws + WS_SSQ), (const unsigned*)(ws + WS_ROPEC), QSCALE, 1.0f / (SA_X * SW_IN)};
                pg8::gemm_phase<pg8::EpiIn, pg8::StaticOrder, true, true, true>(lds + RING_OFF, g, S, E);
            } else {
                pg8::Gemm g{(const bf16*)(ws + WS_XB), (const bf16*)(ws + WS_WIN) + (size_t)l * INW * DM, NTOK, INW, DM, 0};
                pg8::EpiIn E{(bf16*)(ws + WS_PROJ), (const float*)(ws + WS_SSQ), (const unsigned*)(ws + WS_ROPEC), QSCALE, 1.0f};
                pg8::gemm_phase<pg8::EpiIn, pg8::StaticOrder, true, true>(lds + RING_OFF, g, S, E);
            }
            { const int NIi = tailcvt_idle_in(G), nbusy = G - NIi;
              if (NIi > 0 && bx >= nbusy) { const int it = l >> 1, base = (it == 0 ? 0 : TAILCVT_K * tailcvt_idle(ctl, G)) + (l & 1) * TAILCVT_KIN * NIi;
                  const MoeCvt get{ap, ws, it, 2 * it + 1, wave}; cvt_pipeline(get, base + (bx - nbusy), NIi, lane, base + TAILCVT_KIN * NIi); } }
            SEAM(pid);
        }
        ++pid;
        if (PH(pid)) { PHASE_ENV();
            const float* sinks = GIN(ap, I_SINK) + l * 8; const float* hnw = GIN(ap, I_HNW) + l * DM; const float* cw = GIN(ap, I_CONVW) + l * 3 * 512;
            const bf16* PROJ = (const bf16*)(ws + WS_PROJ); bf16* Y = (bf16*)(ws + WS_Y);
            LAS float* sc = (LAS float*)(lds + RING_OFF + wave * 4096);
#if ATTN_NAIVE
            for (int it = gw; it < NTOK * 2; it += NGW) attn_naive_item(it >> 1, it & 1, PROJ, sinks, hnw, Y, sc, lane);
#else
            (void)sc;
            for (int u = gw >> 3; u < 512; u += G) attn_unit(u >> 5, (u >> 4) & 1, u & 15, PROJ, sinks, hnw, Y, lds + RING_OFF, wave, lane);
#endif
            for (int it = gw; it < NTOK / 16; it += NGW) conv_item(it * 16, PROJ, cw, hnw, Y, lane);
            SEAM(pid);
        }
        ++pid;
        if (PH(pid)) { PHASE_ENV();
            pg8::Gemm g{(const bf16*)(ws + WS_Y), (const bf16*)(ws + WS_WOUT) + (size_t)l * DM * DM, NTOK, DM, DM, 0};
            pg8::StaticOrder S; S.init(NTOK, DM, G, bx);
            const bool dense = (l & 1) == 0, f8 = UPF8(l >> 1) != 0;
            pg8::EpiRes E{(bf16*)(ws + WS_XB), (dense && f8) ? ws + WS_XF8 : nullptr, (float*)(ws + WS_SSQ), (PG8_LAS float*)(lds + SSQT_OFF), 1.0f, SA_X};
            pg8::gemm_phase<pg8::EpiRes, pg8::StaticOrder, true, true>(lds + RING_OFF, g, S, E);
            SEAM(pid);
        }
        ++pid;
        if ((l0 & 1) == 0) {
            if (PH(pid)) { PHASE_ENV(); const int i = l >> 1;
                pg8::StaticOrder S; S.init(NTOK, 2 * FF, G, bx);
                const bool upf8 = UPF8(i) != 0, dnf8 = DNF8(i) != 0;
#define DENSE_UP_SITE(F8G, F8O) do { \
                    pg8::Gemm g{(F8G) ? (const bf16*)(ws + WS_XF8) : (const bf16*)(ws + WS_XB), (F8G) ? (const bf16*)(ws + WS_WDUP + (size_t)i * 2 * FF * DM * 2) : (const bf16*)(ws + WS_WDUP) + (size_t)i * 2 * FF * DM, NTOK, 2 * FF, DM, 0}; \
                    pg8::EpiUp<F8O> E{ws + WS_ACT, FF, (const float*)(ws + WS_SSQ), (F8G) ? 1.0f / (SA_X * SW_UP) : 1.0f, SA_ACT}; \
                    pg8::gemm_phase<pg8::EpiUp<F8O>, pg8::StaticOrder, true, true, F8G>(lds + RING_OFF, g, S, E); } while (0)
                if ((DENSE_UP_F8 & DENSE_DN_F8) != 0 && upf8 && dnf8) DENSE_UP_SITE(true, true);
                if ((DENSE_UP_F8 & ~DENSE_DN_F8 & 3) != 0 && upf8 && !dnf8) DENSE_UP_SITE(true, false);
                if ((~DENSE_UP_F8 & DENSE_DN_F8 & 3) != 0 && !upf8 && dnf8) DENSE_UP_SITE(false, true);
                if ((~DENSE_UP_F8 & ~DENSE_DN_F8 & 3) != 0 && !upf8 && !dnf8) DENSE_UP_SITE(false, false);
#undef DENSE_UP_SITE
                SEAM(pid);
            }
            ++pid;
            if (PH(pid)) { PHASE_ENV(); const int i = l >> 1;
                pg8::StaticOrder S; S.init(NTOK, DM, G, bx);
                if (DENSE_DN_F8 != 0 && (DENSE_DN_F8 == 3 || DNF8(i))) {
                    pg8::Gemm g{(const bf16*)(ws + WS_ACT), (const bf16*)(ws + WS_WDDN + (size_t)i * DM * FF * 2), NTOK, DM, FF, 0};
                    pg8::EpiRes E{(bf16*)(ws + WS_XB), INF8(l + 1) ? ws + WS_XF8 : nullptr, (float*)(ws + WS_SSQ), (PG8_LAS float*)(lds + SSQT_OFF), 1.0f / (SA_ACT * SW_DN), SA_X};
                    pg8::gemm_phase<pg8::EpiRes, pg8::StaticOrder, true, true, true>(lds + RING_OFF, g, S, E);
                } else if (DENSE_DN_F8 != 3) {
                    pg8::Gemm g{(const bf16*)(ws + WS_ACT), (const bf16*)(ws + WS_WDDN) + (size_t)i * DM * FF, NTOK, DM, FF, 0};
                    pg8::EpiRes E{(bf16*)(ws + WS_XB), nullptr, (float*)(ws + WS_SSQ), (PG8_LAS float*)(lds + SSQT_OFF), 1.0f, 0.f};
                    pg8::gemm_phase<pg8::EpiRes, pg8::StaticOrder, true, true, false>(lds + RING_OFF, g, S, E);
                }
                SEAM(pid);
            }
            ++pid;
        } else {
            if (PH(pid)) { PHASE_ENV(); const int i = l >> 1;
                p_router(ap, ws, lds, ctl, (const bf16*)(ws + WS_XB), l, i, i, wave, lane, tid, G);
                p_moe_weights(ap, ws, lds, i, gw, NGW, wave, lane, (i == 1 ? TAILCVT_K * tailcvt_idle(ctl, G) : 0) + 2 * TAILCVT_KIN * tailcvt_idle_in(G));
                SEAM(pid);
            }
            ++pid;
            if (PH(pid)) { PHASE_ENV(); const int i = l >> 1;
                const MoeMeta mm = moe_meta(ctl, i);
                pg8::Gemm g{(const bf16*)(ws + WS_XS), (const bf16*)(ws + WS_WMUP + (size_t)i * MOE_SET_UP), mm.ntiles * 256, 2 * FF, DM, (size_t)2 * FF * DM};
                pg8::MoeOrder S; S.init(mm.ntiles * 256, 2 * FF, G, bx); S.acap = NTOK / 256;
#pragma unroll
                for (int e = 0; e < 8; ++e) S.tend[e] = mm.tend[e];
                pg8::EpiUp<true> E{ws + WS_ACT, FF, nullptr, 1.0f / (SA_X * SW_UP), SA_ACT};
                pg8::gemm_phase<pg8::EpiUp<true>, pg8::MoeOrder, true, true, true>(lds + RING_OFF, g, S, E);
                SEAM(pid);
            }
            ++pid;
            if (PH(pid)) { PHASE_ENV(); const int i = l >> 1;
                const MoeMeta mm = moe_meta(ctl, i);
                pg8::Gemm g{(const bf16*)(ws + WS_ACT), (const bf16*)(ws + WS_WMDN + (size_t)i * MOE_SET_DN), mm.ntiles * 256, DM, FF, (size_t)DM * FF};
                pg8::MoeOrder S; S.init(mm.ntiles * 256, DM, G, bx); S.acap = 0;
#pragma unroll
                for (int e = 0; e < 8; ++e) S.tend[e] = mm.tend[e];
                pg8::EpiYs E{ws + WS_YS, DM, S_YS / (SA_ACT * SW_DN)};
                pg8::gemm_phase<pg8::EpiYs, pg8::MoeOrder, true, true, true>(lds + RING_OFF, g, S, E);
                if (i == 0) { const int NI = tailcvt_idle(ctl, G), nbusy = G - NI;
                    if (NI > 0 && bx >= nbusy) { const MoeCvt get{ap, ws, 1, 3, wave}; cvt_pipeline(get, bx - nbusy, NI, lane, TAILCVT_K * NI); } }
                SEAM(pid);
            }
            ++pid;
            if (PH(pid)) { PHASE_ENV(); const int i = l >> 1; p_combine(ap, ws, ctl, (bf16*)(ws + WS_XB), GOUT(ap), (float*)(ws + WS_SSQ), i, l == DEPTH - 1, gw, NGW, lane); SEAM(pid); }
            ++pid;
        }
    }
#undef PH
#undef SEAM
}
constexpr int N_PHASES = 1 + 2 * (3 + 2) + 2 * (3 + 4);

extern "C" void kernel_launch(void* const* d_in, const int* in_sizes, int n_in, void* d_out, int out_size, void* d_ws, size_t ws_size, hipStream_t stream) {
    static int grid = 0;
    if (grid == 0) {
        if (n_in != 17 || out_size != NTOK * DM || ws_size < WS_END) { fprintf(stderr, "kernel_launch: unexpected shapes (n_in %d, out %d, ws %zu < %zu); nothing launched\n", n_in, out_size, ws_size, (size_t)WS_END); grid = -1; return; }
        int dev = 0, cus = 0, per_cu = 0;
        if (hipGetDevice(&dev) != hipSuccess || hipDeviceGetAttribute(&cus, hipDeviceAttributeMultiprocessorCount, dev) != hipSuccess) { grid = -1; return; }
        if (hipFuncSetAttribute((const void*)fwd_kernel, hipFuncAttributeMaxDynamicSharedMemorySize, LDS_BYTES) != hipSuccess) { fprintf(stderr, "kernel_launch: hipFuncSetAttribute failed\n"); grid = -1; return; }
        if (hipOccupancyMaxActiveBlocksPerMultiprocessor(&per_cu, (const void*)fwd_kernel, NWAVES * 64, LDS_BYTES) != hipSuccess || per_cu < 1) fprintf(stderr, "kernel_launch: occupancy query reports %d blocks per CU\n", per_cu);
        (void)hipGetLastError();
        if ((NTOK + cus - 1) / cus > 128) { fprintf(stderr, "kernel_launch: the router phase keeps 128 token rows per workgroup in LDS: needs >= 256 CUs (got %d); nothing launched\n", cus); grid = -1; return; }
        grid = cus;
    }
    if (grid < 0) return;
    if (hipMemsetAsync((char*)d_ws + WS_CTL, 0, CTL_ZERO_BYTES, stream) != hipSuccess) return;
    Args a{};
    for (int i = 0; i < 17; ++i) a.in[i] = (const float*)d_in[i];
    a.out = (float*)d_out; a.ws = (unsigned char*)d_ws;
#if MK_PER_PHASE
    for (int p = 0; p < N_PHASES; ++p) { a.ph_lo = p; a.ph_hi = p + 1; hipLaunchKernelGGL(fwd_kernel, dim3(grid), dim3(NWAVES * 64), LDS_BYTES, stream, a); }
#else
    a.ph_lo = 0; a.ph_hi = N_PHASES;
    hipLaunchKernelGGL(fwd_kernel, dim3(grid), dim3(NWAVES * 64), LDS_BYTES, stream, a);
#endif
}
```
